# Optimizing an MI355X kernel written in HIP

```python
import math
import jax, jax.numpy as jnp
from jax import lax
import numpy as np

D_MODEL = 2048
BATCH = 4
SEQ = 2048
DEPTH = 4
DEC_BATCH = 128
DEC_SEQ = 1
PAST_LEN = 16384
PAGE_SIZE = 128

MIX_WIDTH = D_MODEL
DN_WIDTH = MIX_WIDTH // 2
DN_HEADS = 8
DN_HEAD_DIM = DN_WIDTH // DN_HEADS
CONV_W = 4
CHUNK = 64
POOL_WIDTH = MIX_WIDTH - DN_WIDTH
POOL_WINDOWS = (2, 4, 8, 16)
N_POOL_GROUPS = len(POOL_WINDOWS)
POOL_GROUP = POOL_WIDTH // N_POOL_GROUPS
POOL_BUF = max(POOL_WINDOWS) - 1
D_FF = -(-8 * D_MODEL // (3 * 256)) * 256
IN_COLS = 4 * DN_WIDTH + 2 * DN_HEADS + POOL_WIDTH
EPS = 1e-6

kernel_name = "hymba_gdn_pool_decoder_step"


def rmsnorm(x, w):
    xf = x.astype(jnp.float32)
    y = xf * lax.rsqrt(jnp.mean(xf * xf, axis=-1, keepdims=True) + EPS)
    return (y * w.astype(jnp.float32)).astype(x.dtype)


def l2norm(x):
    xf = x.astype(jnp.float32)
    return xf * lax.rsqrt(jnp.sum(xf * xf, axis=-1, keepdims=True) + EPS)


def short_conv(buf, x, w):
    ext = jnp.concatenate([buf.astype(x.dtype), x], axis=1)
    T = x.shape[1]
    y = ext[:, 0:T] * w[0]
    for i in range(1, CONV_W):
        y = y + ext[:, i:i + T] * w[i]
    return jax.nn.silu(y), ext[:, -(CONV_W - 1):]


def gated_delta_chunked(q, k, v, g, beta, S0):
    B, T, H, K = k.shape
    n = T // CHUNK

    def to_chunks(a):
        a = a.reshape((B, n, CHUNK, H) + a.shape[3:])
        return jnp.moveaxis(a, 3, 1)

    qc, kc, vc, bc = to_chunks(q), to_chunks(k), to_chunks(v), to_chunks(beta)
    gc = jnp.cumsum(to_chunks(g), axis=-1)
    tril = jnp.tril(jnp.ones((CHUNK, CHUNK), bool))
    strict = jnp.tril(jnp.ones((CHUNK, CHUNK), bool), -1)
    diff = gc[..., :, None] - gc[..., None, :]
    decay = jnp.where(tril, jnp.exp(jnp.where(tril, diff, 0.0)), 0.0)
    kb = kc * bc[..., None]
    m = jnp.where(strict, jnp.einsum('bhncd,bhnsd->bhncs', kb, kc) * decay, 0.0)
    a_mat = m + jnp.eye(CHUNK, dtype=m.dtype)
    u = lax.linalg.triangular_solve(a_mat, vc * bc[..., None], left_side=True,
                                    lower=True, unit_diagonal=True)
    w = lax.linalg.triangular_solve(a_mat, kb * jnp.exp(gc)[..., None], left_side=True,
                                    lower=True, unit_diagonal=True)
    qk = jnp.where(tril, jnp.einsum('bhncd,bhnsd->bhncs', qc, kc) * decay, 0.0)

    def step(S, xs):
        q_i, k_i, u_i, w_i, g_i, qk_i = xs
        v_new = u_i - jnp.einsum('bhck,bhkv->bhcv', w_i, S)
        o = (jnp.einsum('bhck,bhkv->bhcv', q_i * jnp.exp(g_i)[..., None], S)
             + jnp.einsum('bhcs,bhsv->bhcv', qk_i, v_new))
        g_last = g_i[..., -1]
        k_dec = k_i * jnp.exp(g_last[..., None] - g_i)[..., None]
        S = S * jnp.exp(g_last)[..., None, None] + jnp.einsum('bhck,bhcv->bhkv', k_dec, v_new)
        return S, o

    xs = tuple(jnp.moveaxis(a, 2, 0) for a in (qc, kc, u, w, gc, qk))
    S, o = lax.scan(step, S0, xs)
    o = jnp.transpose(o, (1, 0, 3, 2, 4)).reshape(B, T, H, -1)
    return o, S


def gated_delta_recurrent(q, k, v, g, beta, S0):
    def step(S, xs):
        q_t, k_t, v_t, g_t, b_t = xs
        S = S * jnp.exp(g_t)[..., None, None]
        kv = jnp.einsum('bhk,bhkv->bhv', k_t, S)
        S = S + jnp.einsum('bhk,bhv->bhkv', k_t, (v_t - kv) * b_t[..., None])
        o = jnp.einsum('bhk,bhkv->bhv', q_t, S)
        return S, o

    xs = tuple(jnp.moveaxis(a, 1, 0) for a in (q, k, v, g, beta))
    S, o = lax.scan(step, S0, xs)
    return jnp.moveaxis(o, 0, 1), S


def multiscale_pool(buf, p, start_pos, w_pool, pool_scale):
    B, T, C = p.shape
    ext = jnp.concatenate([buf.astype(p.dtype), p], axis=1)
    extf = ext.astype(jnp.float32)
    cs = jnp.concatenate([jnp.zeros((B, 1, C), jnp.float32), jnp.cumsum(extf, axis=1)], axis=1)
    pos = start_pos + jnp.arange(T)
    means = []
    for gi, win in enumerate(POOL_WINDOWS):
        lo, hi = gi * POOL_GROUP, (gi + 1) * POOL_GROUP
        s = (cs[:, POOL_BUF + 1:POOL_BUF + 1 + T, lo:hi]
             - cs[:, POOL_BUF + 1 - win:POOL_BUF + 1 - win + T, lo:hi])
        cnt = jnp.minimum(pos + 1, win).astype(jnp.float32)
        means.append(s / cnt[None, :, None])
    d = jnp.concatenate(means, axis=-1) - extf[:, POOL_BUF:]
    d = d.reshape(B, T, N_POOL_GROUPS, POOL_GROUP).astype(p.dtype)
    y = jnp.einsum('btgc,gcd->btgd', d, w_pool).reshape(B, T, POOL_WIDTH) * pool_scale
    return y, ext[:, -POOL_BUF:]


def decoder_layer(h, conv_buf, S0, pool_buf, start_pos, chunked,
                  norm_mix, w_in, conv_w, a_log, dt_bias, dn_norm, w_pool, pool_scale,
                  w_out, norm_ffn, w_gate_up, w_down):
    B, T, _ = h.shape
    xn = rmsnorm(h, norm_mix)
    proj = xn @ w_in
    o0 = 3 * DN_WIDTH
    o1 = 4 * DN_WIDTH
    qkv = proj[..., :o0]
    z = proj[..., o0:o1]
    b_raw = proj[..., o1:o1 + DN_HEADS]
    a_raw = proj[..., o1 + DN_HEADS:o1 + 2 * DN_HEADS]
    p = proj[..., o1 + 2 * DN_HEADS:]

    qkv_c, new_conv = short_conv(conv_buf, qkv, conv_w)
    q = qkv_c[..., :DN_WIDTH].reshape(B, T, DN_HEADS, DN_HEAD_DIM)
    k = qkv_c[..., DN_WIDTH:2 * DN_WIDTH].reshape(B, T, DN_HEADS, DN_HEAD_DIM)
    v = qkv_c[..., 2 * DN_WIDTH:].reshape(B, T, DN_HEADS, DN_HEAD_DIM).astype(jnp.float32)
    q = l2norm(q) * (DN_HEAD_DIM ** -0.5)
    k = l2norm(k)
    beta = jax.nn.sigmoid(b_raw.astype(jnp.float32))
    g = -jnp.exp(a_log.astype(jnp.float32)) * jax.nn.softplus(
        a_raw.astype(jnp.float32) + dt_bias.astype(jnp.float32))
    S0f = S0.astype(jnp.float32)
    if chunked:
        o, S = gated_delta_chunked(q, k, v, g, beta, S0f)
    else:
        o, S = gated_delta_recurrent(q, k, v, g, beta, S0f)
    zf = z.astype(jnp.float32).reshape(B, T, DN_HEADS, DN_HEAD_DIM)
    dn_out = (rmsnorm(o, dn_norm) * jax.nn.silu(zf)).reshape(B, T, DN_WIDTH).astype(h.dtype)

    pool_out, new_pool = multiscale_pool(pool_buf, p, start_pos, w_pool, pool_scale)

    h = h + jnp.concatenate([dn_out, pool_out.astype(h.dtype)], axis=-1) @ w_out

    xn2 = rmsnorm(h, norm_ffn)
    gu = xn2 @ w_gate_up
    h = h + (jax.nn.silu(gu[..., :D_FF]) * gu[..., D_FF:]) @ w_down
    return h, S.astype(h.dtype), new_conv, new_pool


def setup_inputs(seed: int = 0) -> dict:
    key = jax.random.key(seed)
    ks = jax.random.split(key, 20)
    f32 = jnp.float32

    def nrm(k, shape, scale):
        return jax.random.normal(k, shape, f32) * scale

    x_prompt = nrm(ks[0], (BATCH, SEQ, D_MODEL), 1.0)
    x_sample = nrm(ks[1], (DEC_BATCH, DEC_SEQ, D_MODEL), 1.0)
    state_delta = nrm(ks[2], (DEPTH, DEC_BATCH, DN_HEADS, DN_HEAD_DIM, DN_HEAD_DIM), DN_HEAD_DIM ** -0.5)
    state_conv = nrm(ks[3], (DEPTH, DEC_BATCH, CONV_W - 1, 3 * DN_WIDTH), 1.0)
    state_pool = nrm(ks[4], (DEPTH, DEC_BATCH, POOL_BUF, POOL_WIDTH), 1.0)
    norm_mix = 1.0 + nrm(ks[5], (DEPTH, D_MODEL), 0.02)
    w_in = nrm(ks[6], (DEPTH, D_MODEL, IN_COLS), D_MODEL ** -0.5)
    conv_w = nrm(ks[7], (DEPTH, CONV_W, 3 * DN_WIDTH), CONV_W ** -0.5)
    a_log = jnp.log(jax.random.uniform(ks[8], (DEPTH, DN_HEADS), f32, 1.0, 16.0))
    dt = jnp.exp(jax.random.uniform(ks[9], (DEPTH, DN_HEADS), f32, math.log(1e-3), math.log(1e-1)))
    dt_bias = dt + jnp.log(-jnp.expm1(-dt))
    dn_norm = 1.0 + nrm(ks[10], (DEPTH, DN_HEAD_DIM), 0.02)
    w_pool = nrm(ks[11], (DEPTH, N_POOL_GROUPS, POOL_GROUP, POOL_GROUP), POOL_GROUP ** -0.5)
    pool_scale = 1.0 + nrm(ks[12], (DEPTH, POOL_WIDTH), 0.1)
    w_out = nrm(ks[13], (DEPTH, MIX_WIDTH, D_MODEL), (2 * DEPTH * MIX_WIDTH) ** -0.5)
    norm_ffn = 1.0 + nrm(ks[14], (DEPTH, D_MODEL), 0.02)
    w_gate_up = nrm(ks[15], (DEPTH, D_MODEL, 2 * D_FF), D_MODEL ** -0.5)
    w_down = nrm(ks[16], (DEPTH, D_FF, D_MODEL), (2 * DEPTH * D_FF) ** -0.5)
    norm_final = 1.0 + nrm(ks[17], (D_MODEL,), 0.02)
    return {"x_prompt": x_prompt, "x_sample": x_sample,
            "state_delta": state_delta, "state_conv": state_conv, "state_pool": state_pool,
            "norm_mix": norm_mix, "w_in": w_in, "conv_w": conv_w, "a_log": a_log,
            "dt_bias": dt_bias, "dn_norm": dn_norm, "w_pool": w_pool, "pool_scale": pool_scale,
            "w_out": w_out, "norm_ffn": norm_ffn, "w_gate_up": w_gate_up, "w_down": w_down,
            "norm_final": norm_final}


def reference(x_prompt, x_sample, state_delta, state_conv, state_pool, norm_mix, w_in, conv_w,
              a_log, dt_bias, dn_norm, w_pool, pool_scale, w_out, norm_ffn, w_gate_up, w_down,
              norm_final):
    hp, hs = x_prompt, x_sample
    dtp = x_prompt.dtype
    zero_S = jnp.zeros((BATCH, DN_HEADS, DN_HEAD_DIM, DN_HEAD_DIM), jnp.float32)
    zero_conv = jnp.zeros((BATCH, CONV_W - 1, 3 * DN_WIDTH), dtp)
    zero_pool = jnp.zeros((BATCH, POOL_BUF, POOL_WIDTH), dtp)
    dp, cp, pp, ds, cs, ps = [], [], [], [], [], []
    for l in range(DEPTH):
        lw = (norm_mix[l], w_in[l], conv_w[l], a_log[l], dt_bias[l], dn_norm[l], w_pool[l],
              pool_scale[l], w_out[l], norm_ffn[l], w_gate_up[l], w_down[l])
        hp, S_p, c_p, p_p = decoder_layer(hp, zero_conv, zero_S, zero_pool, 0, True, *lw)
        hs, S_s, c_s, p_s = decoder_layer(hs, state_conv[l], state_delta[l], state_pool[l],
                                          PAST_LEN, False, *lw)
        dp.append(S_p); cp.append(c_p); pp.append(p_p)
        ds.append(S_s); cs.append(c_s); ps.append(p_s)
    y_prompt = rmsnorm(hp, norm_final)
    y_sample = rmsnorm(hs, norm_final)
    return (y_prompt, y_sample, jnp.stack(dp), jnp.stack(cp), jnp.stack(pp),
            jnp.stack(ds), jnp.stack(cs), jnp.stack(ps))
```

```cpp
#include <hip/hip_runtime.h>
#include <cstdio>
#include <cstdint>

#ifndef MK_N_LAUNCHES
#define MK_N_LAUNCHES 1
#endif

namespace pg8 {
#define PG8_LAS __attribute__((address_space(3)))
typedef unsigned short bf16_t;
typedef short bf16x8 __attribute__((ext_vector_type(8)));
typedef float f32x4 __attribute__((ext_vector_type(4)));
typedef unsigned u32x4 __attribute__((ext_vector_type(4)));
typedef unsigned u32x2 __attribute__((ext_vector_type(2)));
constexpr int BM = 256, BK = 64, HALF = 128, HTB = HALF * BK * 2, STAGE_BYTES = 8 * HTB, NXCD = 8, WGM = 4;

__host__ __device__ __forceinline__ int lds_byte(int r, int c) { const int st = (r >> 4) * 2 + (c >> 5), rr = r & 15, cc = c & 31, ob = rr * 64 + cc * 2; return st * 1024 + (ob ^ (((ob >> 9) & 1) << 5)); }
__host__ __device__ __forceinline__ void stage_rc(int b, int& R, int& C) { const int st = b / 1024, sb = b % 1024, swz = sb ^ (((sb >> 9) & 1) << 5); R = (st >> 1) * 16 + swz / 64; C = (st & 1) * 32 + (swz % 64) / 2; }
__host__ __device__ __forceinline__ int perm32(int rho) { const int n = rho >> 4, i = rho & 15; return 8 * (i >> 2) + 4 * n + (i & 3); }

struct Unit { int pm, pn; };
struct Gemm { const bf16_t* A; const bf16_t* Bt; int M, N, K, lda, ldb; long a_pn_bytes; };

struct StaticOrder {
    int nM, nN, nwg, G, c;
    __host__ __device__ void init(int M, int N, int G_, int c_) { nM = M / BM; nN = N / BM; nwg = nM * nN; G = G_; c = c_; }
    __host__ __device__ bool next(int i, Unit& u) const {
        const long L = (long)i * G + c; if (L >= nwg) return false;
        int wgid = (int)L; { const int q = nwg / NXCD, r = nwg % NXCD, xcd = wgid % NXCD, off = wgid / NXCD; wgid = (xcd < r ? xcd * (q + 1) : r * (q + 1) + (xcd - r) * q) + off; }
        const int nig = WGM * nN, gid = wgid / nig, fm = gid * WGM, gsz = (nM - fm) < WGM ? (nM - fm) : WGM;
        u.pm = fm + ((wgid % nig) % gsz); u.pn = (wgid % nig) / gsz; return true;
    }
    __device__ __forceinline__ void a_ready(const Unit&) const {}
    __device__ __forceinline__ void done(const Unit&) const {}
};

__device__ __forceinline__ unsigned cvt_pk_bf16(float lo, float hi) { unsigned r; asm volatile("v_cvt_pk_bf16_f32 %0, %1, %2" : "=v"(r) : "v"(lo), "v"(hi)); return r; }

template <class Epi, class Sched, bool ALIGN_EPI = false, bool SP2 = false>
__device__ __forceinline__ void gemm_phase(PG8_LAS unsigned char* lds, const Gemm g, const Sched& S, const Epi& E) {
    int tid_ = threadIdx.x; asm volatile("" : "+v"(tid_));
    const int tid = tid_, wid = __builtin_amdgcn_readfirstlane(tid >> 6), lane = tid & 63, wr = wid >> 2, wc = wid & 3, fr = lane & 15, fq = lane >> 4;
    const int K = g.K, nt = K / BK;
    unsigned voffA[2], voffB[2];
#pragma unroll
    for (int i = 0; i < 2; ++i) { int R, C; stage_rc(tid * 16 + i * 8192, R, C); const int Rb = Epi::PERM ? ((R & ~31) + perm32(R & 31)) : R;
        voffA[i] = (unsigned)(R * g.lda + C) * 2u; voffB[i] = (unsigned)(Rb * g.ldb + C) * 2u; }
    const size_t kstep = (size_t)(BK * 2);
    const size_t hstepA = (size_t)HALF * g.lda * 2, hstepB = (size_t)HALF * g.ldb * 2;
    const size_t tstepA = 2 * hstepA, tstepB = 2 * hstepB;
    const unsigned ldsw = (unsigned)wid * 1024u;
    const int aoff = lds_byte(wr * 64 + fr, fq * 8), boff = lds_byte(wc * 32 + fr, fq * 8);
#define PG8_SA(b, h) (((b) * 2 + (h)) * HTB)
#define PG8_SB(b, h) ((4 + (b) * 2 + (h)) * HTB)
#define PG8_STAGE(bufoff, gbase, voff) do { _Pragma("unroll") for (int _i = 0; _i < 2; ++_i) { unsigned _vo = (voff)[_i]; asm volatile("" : "+v"(_vo));   \
        __builtin_amdgcn_global_load_lds((const unsigned*)((const char*)(gbase) + _vo), (PG8_LAS unsigned*)(lds + (bufoff) + ldsw + _i * 8192), 16, 0, 0); } } while (0)
#define PG8_LDA(dst, b, h) do { _Pragma("unroll") for (int m = 0; m < 4; ++m) _Pragma("unroll") for (int k = 0; k < 2; ++k) dst[m][k] = *(const PG8_LAS bf16x8*)(lds + PG8_SA(b, h) + aoff + m * 2048 + k * 1024); } while (0)
#define PG8_LDB(dst, b, h) do { _Pragma("unroll") for (int n = 0; n < 2; ++n) _Pragma("unroll") for (int k = 0; k < 2; ++k) dst[n][k] = *(const PG8_LAS bf16x8*)(lds + PG8_SB(b, h) + boff + n * 2048 + k * 1024); } while (0)
#define PG8_MMA(ai, bj, At, Bt) do { __builtin_amdgcn_s_setprio(1); _Pragma("unroll") for (int m = 0; m < 4; ++m) _Pragma("unroll") for (int n = 0; n < 2; ++n) _Pragma("unroll") for (int k = 0; k < 2; ++k) \
        acc[ai][bj][m][n] = __builtin_amdgcn_mfma_f32_16x16x32_bf16(Bt[n][k], At[m][k], acc[ai][bj][m][n], 0, 0, 0); __builtin_amdgcn_s_setprio(0); } while (0)
#define PG8_WAIT_V(n) asm volatile("s_waitcnt vmcnt(" #n ")" ::: "memory")
#define PG8_WAIT_L(n) asm volatile("s_waitcnt lgkmcnt(" #n ")" ::: "memory")
#define PG8_BAR __builtin_amdgcn_s_barrier()
#define PG8_SCHED __builtin_amdgcn_sched_barrier(0)
    Unit cur, nxt; int ui = 0;
    if (!S.next(0, cur)) return;
    f32x4 acc[2][2][4][2];
#pragma unroll
    for (int a = 0; a < 2; ++a)
#pragma unroll
        for (int b = 0; b < 2; ++b)
#pragma unroll
            for (int m = 0; m < 4; ++m)
#pragma unroll
                for (int n = 0; n < 2; ++n) acc[a][b][m][n] = (f32x4){0.f, 0.f, 0.f, 0.f};
    bf16x8 At[4][2], B0[2][2], B1[2][2];
    const char* cA = (const char*)g.A + (size_t)cur.pm * tstepA + (size_t)cur.pn * g.a_pn_bytes; const char* cB = (const char*)g.Bt + (size_t)cur.pn * tstepB;
    S.a_ready(cur);
    if constexpr (SP2) {
        PG8_STAGE(PG8_SB(0, 0), cB, voffB); PG8_STAGE(PG8_SB(0, 1), cB + hstepB, voffB); PG8_STAGE(PG8_SA(0, 0), cA, voffA); PG8_STAGE(PG8_SA(0, 1), cA + hstepA, voffA);
        if (wr == 1) PG8_BAR;
        PG8_WAIT_V(2); PG8_BAR;
        PG8_STAGE(PG8_SB(1, 0), cB + kstep, voffB); PG8_STAGE(PG8_SA(1, 0), cA + kstep, voffA); PG8_STAGE(PG8_SB(1, 1), cB + hstepB + kstep, voffB);
        PG8_WAIT_V(6); PG8_BAR;
    } else {
        PG8_STAGE(PG8_SB(0, 0), cB, voffB); PG8_STAGE(PG8_SA(0, 0), cA, voffA); PG8_STAGE(PG8_SB(0, 1), cB + hstepB, voffB); PG8_STAGE(PG8_SA(0, 1), cA + hstepA, voffA);
        if (wr == 1) PG8_BAR;
        PG8_WAIT_V(4); PG8_BAR;
        PG8_STAGE(PG8_SB(1, 0), cB + kstep, voffB); PG8_STAGE(PG8_SA(1, 0), cA + kstep, voffA); PG8_STAGE(PG8_SB(1, 1), cB + hstepB + kstep, voffB);
        PG8_WAIT_V(6); PG8_BAR;
    }
    for (;;) {
        const bool has_next = S.next(ui + 1, nxt);
        const char* nA = has_next ? (const char*)g.A + (size_t)nxt.pm * tstepA + (size_t)nxt.pn * g.a_pn_bytes : cA; const char* nB = has_next ? (const char*)g.Bt + (size_t)nxt.pn * tstepB : cB;
        for (int t = 0; t < nt; t += 2) {
            const bool last = (t == nt - 2);
            const char* a1 = cA + (size_t)(t + 1) * kstep;
            const char* a2 = last ? nA : cA + (size_t)(t + 2) * kstep; const char* b2 = last ? nB : cB + (size_t)(t + 2) * kstep;
            const char* a3 = a2 + kstep; const char* b3 = b2 + kstep;
            if (last && has_next) S.a_ready(nxt);
            if constexpr (SP2) {
            PG8_LDB(B0, 0, 0); PG8_LDB(B1, 0, 1); PG8_SCHED; PG8_LDA(At, 0, 0); PG8_STAGE(PG8_SA(1, 1), a1 + hstepA, voffA);
            PG8_WAIT_V(8); PG8_WAIT_L(0); PG8_BAR; PG8_MMA(0, 0, At, B0); PG8_MMA(0, 1, At, B1); PG8_BAR; PG8_SCHED;
            PG8_LDA(At, 0, 1); PG8_STAGE(PG8_SB(0, 0), b2, voffB); PG8_STAGE(PG8_SB(0, 1), b2 + hstepB, voffB); PG8_STAGE(PG8_SA(0, 0), a2, voffA);
            PG8_WAIT_V(8); PG8_WAIT_L(0); PG8_BAR; PG8_MMA(1, 0, At, B0); PG8_MMA(1, 1, At, B1); PG8_BAR; PG8_SCHED;
            PG8_LDB(B0, 1, 0); PG8_LDB(B1, 1, 1); PG8_SCHED; PG8_LDA(At, 1, 0); PG8_STAGE(PG8_SA(0, 1), a2 + hstepA, voffA);
            PG8_WAIT_V(8); PG8_WAIT_L(0); PG8_BAR; PG8_MMA(0, 0, At, B0); PG8_MMA(0, 1, At, B1); PG8_BAR; PG8_SCHED;
            PG8_LDA(At, 1, 1); PG8_STAGE(PG8_SB(1, 0), b3, voffB); PG8_STAGE(PG8_SB(1, 1), b3 + hstepB, voffB); PG8_STAGE(PG8_SA(1, 0), a3, voffA);
            PG8_WAIT_V(8); PG8_WAIT_L(0); PG8_BAR; PG8_MMA(1, 0, At, B0); PG8_MMA(1, 1, At, B1); PG8_BAR; PG8_SCHED;
            } else {
            PG8_LDB(B0, 0, 0); PG8_SCHED; PG8_LDA(At, 0, 0); PG8_STAGE(PG8_SA(1, 1), a1 + hstepA, voffA);
            PG8_WAIT_L(8); PG8_BAR; PG8_WAIT_L(0); PG8_MMA(0, 0, At, B0); PG8_BAR; PG8_SCHED;
            PG8_LDB(B1, 0, 1); PG8_STAGE(PG8_SB(0, 0), b2, voffB);
            PG8_BAR; PG8_WAIT_L(0); PG8_MMA(0, 1, At, B1); PG8_BAR;
            PG8_LDA(At, 0, 1); PG8_STAGE(PG8_SA(0, 0), a2, voffA);
            PG8_BAR; PG8_WAIT_L(0); PG8_MMA(1, 0, At, B0); PG8_BAR; PG8_SCHED;
            PG8_STAGE(PG8_SB(0, 1), b2 + hstepB, voffB);
            PG8_WAIT_V(6); PG8_BAR; PG8_MMA(1, 1, At, B1); PG8_BAR;
            PG8_LDB(B0, 1, 0); PG8_SCHED; PG8_LDA(At, 1, 0); PG8_STAGE(PG8_SA(0, 1), a2 + hstepA, voffA);
            PG8_WAIT_L(8); PG8_BAR; PG8_WAIT_L(0); PG8_MMA(0, 0, At, B0); PG8_BAR; PG8_SCHED;
            PG8_LDB(B1, 1, 1); PG8_STAGE(PG8_SB(1, 0), b3, voffB);
            PG8_BAR; PG8_WAIT_L(0); PG8_MMA(0, 1, At, B1); PG8_BAR;
            PG8_LDA(At, 1, 1); PG8_STAGE(PG8_SA(1, 0), a3, voffA);
            PG8_BAR; PG8_WAIT_L(0); PG8_MMA(1, 0, At, B0); PG8_BAR; PG8_SCHED;
            PG8_STAGE(PG8_SB(1, 1), b3 + hstepB, voffB);
            PG8_WAIT_V(6); PG8_BAR; PG8_MMA(1, 1, At, B1); PG8_BAR;
            }
        }
        if constexpr (ALIGN_EPI) { if (wr == 0) PG8_BAR; }
        E(acc, cur, wr, wc, fr, fq); S.done(cur);
        if (!has_next) break;
#pragma unroll
        for (int a = 0; a < 2; ++a)
#pragma unroll
            for (int b = 0; b < 2; ++b)
#pragma unroll
                for (int m = 0; m < 4; ++m)
#pragma unroll
                    for (int n = 0; n < 2; ++n) acc[a][b][m][n] = (f32x4){0.f, 0.f, 0.f, 0.f};
        cur = nxt; cA = nA; cB = nB; ++ui;
        if constexpr (ALIGN_EPI) { if (wr == 1) PG8_BAR; }
    }
    PG8_WAIT_V(0);
    if constexpr (!ALIGN_EPI) { if (wr == 0) PG8_BAR; }
    PG8_BAR;
#undef PG8_SA
#undef PG8_SB
#undef PG8_STAGE
#undef PG8_LDA
#undef PG8_LDB
#undef PG8_MMA
#undef PG8_WAIT_V
#undef PG8_WAIT_L
#undef PG8_BAR
#undef PG8_SCHED
}
}

constexpr int NWAVES = 8, NTHR = 512;
constexpr int DM = 2048, NB = 4, SEQ = 2048, DEPTH = 4, DECB = 128;
constexpr int DNW = 1024, NH = 8, HD = 128, POOLW = 1024, DFF = 5632, INC = 5136;
constexpr int MP = NB * SEQ;
constexpr int MR = MP + DECB;
constexpr int MPAD = 8448;
constexpr int NIN = 5376;
constexpr int PROJ_LD = 5120;
constexpr float EPS = 1e-6f;

constexpr size_t O_YP = 0, O_YS = 16777216, O_DP = 17039360, O_CP = 19136512, O_PP = 19283968, O_DS = 19529728, O_CS = 86638592, O_PS = 91357184, O_END = 99221504;

constexpr size_t MiB = 1u << 20;
constexpr size_t WS_CTL = 0, CTL_ZERO_BYTES = 1 * MiB;
constexpr size_t SZ_WIN = (size_t)NIN * DM * 2, SZ_WOUT = (size_t)DM * DM * 2, SZ_WGU = (size_t)2 * DFF * DM * 2, SZ_WD = (size_t)DM * DFF * 2, SZ_WP = (size_t)4 * 256 * 256 * 2;
constexpr size_t WS_WIN = 2 * MiB;
constexpr size_t WS_WOUT = WS_WIN + DEPTH * SZ_WIN;
constexpr size_t WS_WGU = WS_WOUT + DEPTH * SZ_WOUT;
constexpr size_t WS_WD = WS_WGU + DEPTH * SZ_WGU;
constexpr size_t WS_WP = WS_WD + DEPTH * SZ_WD;
constexpr size_t WS_H = WS_WP + DEPTH * SZ_WP;
constexpr size_t WS_HB = WS_H + (size_t)MPAD * DM * 4;
constexpr size_t WS_PROJ = WS_HB + (size_t)MPAD * DM * 2;
constexpr size_t WS_BA = WS_PROJ + (size_t)MPAD * PROJ_LD * 2;
constexpr size_t WS_CAT = WS_BA + (size_t)MPAD * 16 * 4;
constexpr size_t WS_DB = WS_CAT + (size_t)MPAD * DM * 2;
constexpr size_t WS_ACT = WS_DB + (size_t)MPAD * POOLW * 2;
constexpr size_t WS_SSQ = WS_ACT + (size_t)MPAD * DFF * 2;
constexpr int NUNIT = NB * NH * (SEQ / 64);
constexpr size_t WS_DW = WS_SSQ + (size_t)MPAD * 32 * 4;
constexpr size_t WS_DQG = WS_DW + (size_t)NUNIT * 64 * 128 * 2;
constexpr size_t WS_DQK = WS_DQG + (size_t)NUNIT * 64 * 128 * 2;
constexpr size_t WS_DKD = WS_DQK + (size_t)NUNIT * 64 * 64 * 2;
constexpr size_t WS_DU = WS_DKD + (size_t)NUNIT * 128 * 64 * 2;
constexpr size_t WS_EGL = WS_DU + (size_t)NUNIT * 128 * 64 * 4;
constexpr size_t WS_OB = WS_EGL + (size_t)NUNIT * 4;
constexpr size_t WS_OSSQ = WS_OB + (size_t)MP * DNW * 4;
constexpr size_t WS_DSSQ = WS_OSSQ + (size_t)MP * 64 * 4;
constexpr size_t WS_END = WS_DSSQ + (size_t)DECB * 64 * 4;
constexpr int CW_BAR = 4096, CW_SCAN = 8192;

constexpr int LDS_BYTES = 147456;
constexpr int MISC_OFF = 131072 + 8192 + 4096;

#define LAS __attribute__((address_space(3)))
typedef unsigned short bf16;
typedef unsigned v4u __attribute__((ext_vector_type(4)));
typedef unsigned v2u __attribute__((ext_vector_type(2)));
typedef float f32x4 __attribute__((ext_vector_type(4)));
#define LDS_WAIT() asm volatile("s_waitcnt lgkmcnt(0)" ::: "memory")
#define VM_WAIT() asm volatile("s_waitcnt vmcnt(0)" ::: "memory")
__device__ __forceinline__ unsigned f2bf(float f) { unsigned u = __builtin_bit_cast(unsigned, f); return (u + 0x7fffu + ((u >> 16) & 1u)) >> 16; }
__device__ __forceinline__ unsigned pk2(float lo, float hi) { return f2bf(lo) | (f2bf(hi) << 16); }
__device__ __forceinline__ float bf2f(bf16 b) { return __builtin_bit_cast(float, ((unsigned)b) << 16); }
__device__ __forceinline__ float silu_f(float x) { return x * __builtin_amdgcn_rcpf(1.0f + __expf(-x)); }
__device__ __forceinline__ float sigmoid_f(float x) { return __builtin_amdgcn_rcpf(1.0f + __expf(-x)); }
__device__ __forceinline__ float softplus_f(float x) { const float e = __expf(x); const float sm = e * (1.0f - e * (0.5f - e * 0.33333333f)); const float lg = __logf(1.0f + e); return x > 20.f ? x : (e < 0.01f ? sm : lg); }
__device__ __forceinline__ float rsqrt_f(float x) { return __builtin_amdgcn_rsqf(x); }
__device__ __forceinline__ float dpp_f(float v, const int ctrl_sel) { return v; }
#define DPP_ADD(v, ctrl, rmask) do { const int t_ = __builtin_amdgcn_update_dpp(0, __builtin_bit_cast(int, (v)), (ctrl), (rmask), 0xF, false); (v) += __builtin_bit_cast(float, t_); } while (0)
__device__ __forceinline__ float row_sum16(float v) {
    DPP_ADD(v, 0xB1, 0xF);
    DPP_ADD(v, 0x4E, 0xF);
    DPP_ADD(v, 0x141, 0xF);
    DPP_ADD(v, 0x140, 0xF);
    return v;
}
__device__ __forceinline__ float wave_sum(float v) {
    v = row_sum16(v);
    DPP_ADD(v, 0x142, 0xA);
    DPP_ADD(v, 0x143, 0xC);
    return __builtin_bit_cast(float, __builtin_amdgcn_readlane(__builtin_bit_cast(int, v), 63));
}

#define XB_TMO      128
#define XB_XCNT(j)  (256  + 64 * (j))
#define XB_XSUB(j)  (1280 + 64 * (j))
#define XB_XGEN(j)  (2304 + 64 * (j))
#define XB_TOP      3328
#define XB_TOPGEN   3392
#define XCD_BAR_WORDS 3456
#define XB_SPIN_CAP (1u << 22)
__device__ __forceinline__ unsigned xb_ld(unsigned* p)              { return __hip_atomic_load(p, __ATOMIC_RELAXED, __HIP_MEMORY_SCOPE_AGENT); }
__device__ __forceinline__ unsigned xb_add(unsigned* p, unsigned v) { return __hip_atomic_fetch_add(p, v, __ATOMIC_RELAXED, __HIP_MEMORY_SCOPE_AGENT); }
__device__ __forceinline__ unsigned xb_xcc_id() { return (unsigned)__builtin_amdgcn_s_getreg((3 << 11) | 20) & 0xFu; }
#define XB_SPIN(cond, bar) do { unsigned _sp = 0; while (cond) { __builtin_amdgcn_s_sleep(1); \
    if ((++_sp & 255u) == 0u) { if (xb_ld(&(bar)[XB_TMO])) break; if (_sp > XB_SPIN_CAP) { atomicAdd(&(bar)[XB_TMO], 1u); break; } } } } while (0)
struct XcdBarrier { unsigned* bar; unsigned x; volatile LAS unsigned* st; };
__device__ __forceinline__ XcdBarrier xcd_barrier_post(unsigned* bar, volatile LAS unsigned* st) {
    XcdBarrier b; b.bar = bar; b.x = xb_xcc_id(); b.st = st;
    if (threadIdx.x == 0) (void)xb_add(&bar[XB_XCNT(b.x)], 1u);
    return b;
}
__device__ __forceinline__ void xcd_barrier_complete(unsigned* bar, unsigned x, unsigned& nloc, unsigned& nx) {
    const unsigned G = gridDim.x * gridDim.y * gridDim.z;
    unsigned sum, cnt, mine, sp = 0u;
    for (;;) {
        sum = 0u; cnt = 0u; mine = 0u;
#pragma unroll
        for (unsigned j = 0; j < 16; ++j) { const unsigned c = xb_ld(&bar[XB_XCNT(j)]); sum += c; cnt += (c > 0u) ? 1u : 0u; mine = (j == x) ? c : mine; }
        if (sum == G) break;
        __builtin_amdgcn_s_sleep(1);
        if ((++sp & 255u) == 0u) { if (xb_ld(&bar[XB_TMO])) break; if (sp > XB_SPIN_CAP) { atomicAdd(&bar[XB_TMO], 1u); break; } }
    }
    nloc = mine > 0u ? mine : 1u; nx = cnt > 0u ? cnt : 1u;
}
__device__ __forceinline__ void xcd_barrier(const XcdBarrier& b) {
    asm volatile("s_waitcnt vmcnt(0)" ::: "memory");
    __syncthreads();
    if (threadIdx.x == 0) {
        unsigned* bar = b.bar;
        __builtin_amdgcn_s_waitcnt(0);
        unsigned nloc = b.st[0], nx = b.st[1];
        if (nloc == 0u) { xcd_barrier_complete(bar, b.x, nloc, nx); b.st[0] = nloc; b.st[1] = nx; }
        const unsigned old = xb_add(&bar[XB_XSUB(b.x)], 1u);
        const unsigned gen = old / nloc;
        if (old + 1u == (gen + 1u) * nloc) {
            __builtin_amdgcn_fence(__ATOMIC_RELEASE, "agent");
            asm volatile("s_waitcnt vmcnt(0)" ::: "memory");
            const unsigned og = xb_add(&bar[XB_TOP], 1u);
            const unsigned tg = og / nx;
            if (og + 1u == (tg + 1u) * nx) xb_add(&bar[XB_TOPGEN], 1u);
            else XB_SPIN(xb_ld(&bar[XB_TOPGEN]) == tg, bar);
            __builtin_amdgcn_fence(__ATOMIC_ACQUIRE, "agent");
            xb_add(&bar[XB_XGEN(b.x)], 1u);
            asm volatile("s_waitcnt vmcnt(0)" ::: "memory");
        } else {
            XB_SPIN(xb_ld(&bar[XB_XGEN(b.x)]) == gen, bar);
            __builtin_amdgcn_fence(__ATOMIC_ACQUIRE, "agent");
            asm volatile("s_waitcnt vmcnt(0)" ::: "memory");
        }
    }
    __syncthreads();
}

struct Args {
    const float *x_prompt, *x_sample, *state_delta, *state_conv, *state_pool, *norm_mix, *w_in, *conv_w, *a_log, *dt_bias, *dn_norm, *w_pool, *pool_scale, *w_out, *norm_ffn, *w_gate_up, *w_down, *norm_final;
    float* out; unsigned char* ws; int ph_lo, ph_hi;
};

__device__ __forceinline__ void tr_item(const float* W, int ldw, const float* kscale, bf16* WT, int K, int k0, int d0, int sc, LAS float* scr, int lane) {
    float tv[32];
#pragma unroll
    for (int i = 0; i < 32; ++i) { const int kk = 2 * i + (lane >> 5); tv[i] = sc >= 0 ? W[(size_t)(k0 + kk) * ldw + sc] : 0.f; }
#pragma unroll
    for (int i = 0; i < 32; ++i) { const int kk = 2 * i + (lane >> 5); float v = tv[i]; if (kscale) v *= kscale[k0 + kk]; scr[kk * 33 + (lane & 31)] = v; }
    LDS_WAIT(); asm volatile("" ::: "memory");
    const int c = lane & 7;
#pragma unroll
    for (int j = 0; j < 4; ++j) { const int n = (lane >> 3) + 8 * j; const LAS float* s = scr + (8 * c) * 33 + n;
        v4u o; o.x = pk2(s[0 * 33], s[1 * 33]); o.y = pk2(s[2 * 33], s[3 * 33]); o.z = pk2(s[4 * 33], s[5 * 33]); o.w = pk2(s[6 * 33], s[7 * 33]);
        *(v4u*)(WT + (size_t)(d0 + n) * K + k0 + 8 * c) = o; }
    LDS_WAIT(); asm volatile("" ::: "memory");
}
__device__ __forceinline__ int srccol_in(int d) { return d < 4096 ? d : (d < 5120 ? d + 16 : (d < 5136 ? d - 1024 : -1)); }
__device__ __forceinline__ int srccol_gu(int d) { const int j = d >> 8, w = d & 255; return w < 128 ? 128 * j + w : DFF + 128 * j + (w - 128); }
constexpr int I_IN = 32 * (NIN / 32), I_OUT = 32 * 64, I_GU = 32 * (2 * DFF / 32), I_D = (DFF / 64) * 64, I_P = 4 * 4 * 8, I_L = I_IN + I_OUT + I_GU + I_D + I_P;
constexpr int CV_PER_WG = 24;
constexpr int CV_A = 96 * CV_PER_WG, CV_B = 128 * CV_PER_WG;
struct CvP { const float *w_in, *norm_mix, *w_out, *w_gate_up, *norm_ffn, *w_down, *w_pool; bf16 *WinT, *WoutT, *WguT, *WdT, *WpT; };
__device__ __forceinline__ void convert_item(const CvP& C, int l, int r, LAS float* scr, int lane) {
    if (r < I_IN) { const int nblk = NIN / 32, kb = r / nblk, nb = r % nblk; tr_item(C.w_in + (size_t)l * DM * INC, INC, C.norm_mix + l * DM, C.WinT + (size_t)l * NIN * DM, DM, 64 * kb, 32 * nb, srccol_in(32 * nb + (lane & 31)), scr, lane); return; } r -= I_IN;
    if (r < I_OUT) { const int kb = r / 64, nb = r % 64; tr_item(C.w_out + (size_t)l * DM * DM, DM, nullptr, C.WoutT + (size_t)l * DM * DM, DM, 64 * kb, 32 * nb, 32 * nb + (lane & 31), scr, lane); return; } r -= I_OUT;
    if (r < I_GU) { const int nblk = 2 * DFF / 32, kb = r / nblk, nb = r % nblk; tr_item(C.w_gate_up + (size_t)l * DM * 2 * DFF, 2 * DFF, C.norm_ffn + l * DM, C.WguT + (size_t)l * 2 * DFF * DM, DM, 64 * kb, 32 * nb, srccol_gu(32 * nb + (lane & 31)), scr, lane); return; } r -= I_GU;
    if (r < I_D) { const int kb = r / 64, nb = r % 64; tr_item(C.w_down + (size_t)l * DFF * DM, DM, nullptr, C.WdT + (size_t)l * DM * DFF, DFF, 64 * kb, 32 * nb, 32 * nb + (lane & 31), scr, lane); return; } r -= I_D;
    { const int g = r / 32, rr = r % 32, kb = rr / 8, nb = rr % 8; tr_item(C.w_pool + (size_t)(l * 4 + g) * 65536, 256, nullptr, C.WpT + (size_t)(l * 4 + g) * 65536, 256, 64 * kb, 32 * nb, 32 * nb + (lane & 31), scr, lane); }
}
__device__ __forceinline__ void convert_tail(const CvP& C, LAS unsigned char* lds, int l_next, int base, int si, int ns, int quota) {
    if (si < 0) return;
    int tl = threadIdx.x; asm volatile("" : "+v"(tl)); const int lane = tl & 63, wave = __builtin_amdgcn_readfirstlane(tl >> 6);
    LAS float* scr = (LAS float*)(lds + wave * 16384);
    for (int j = wave; j < CV_PER_WG; j += NWAVES) { const int r = j * ns + si; if (r < quota) convert_item(C, l_next, base + r, scr, lane); }
    __syncthreads();
}

__device__ __forceinline__ float row_scale1(const float* ssq, int row, int fq) {
    const f32x4* p = (const f32x4*)(ssq + (size_t)row * 32 + 8 * fq); const f32x4 a = p[0], b = p[1];
    float s = ((a[0] + a[1]) + (a[2] + a[3])) + ((b[0] + b[1]) + (b[2] + b[3])); s += __shfl_xor(s, 16); s += __shfl_xor(s, 32);
    return rsqrt_f(s * (1.0f / DM) + EPS);
}
#define EPI_FENCE() asm volatile("" ::: "memory")
struct EpiIn {
    static constexpr bool PERM = true;
    bf16* proj; float* ba; const float* ssq;
    __device__ __forceinline__ void operator()(const f32x4 (&acc)[2][2][4][2], const pg8::Unit& u, int wr, int wc, int fr_, int fq_) const {
        int fr = fr_, fq = fq_; asm volatile("" : "+v"(fr), "+v"(fq));
        const int row0 = u.pm * 256 + wr * 64 + fr;
        if (u.pn < 20) {
            const int col0 = u.pn * 256 + wc * 32 + 8 * fq;
#pragma unroll
            for (int ai = 0; ai < 2; ++ai)
#pragma unroll
                for (int m = 0; m < 4; ++m) { const int row = row0 + ai * 128 + m * 16; bf16* rowp = proj + (size_t)row * PROJ_LD + col0; const float r = row_scale1(ssq, row, fq);
#pragma unroll
                    for (int bj = 0; bj < 2; ++bj) { const f32x4 v0 = acc[ai][bj][m][0] * r, v1 = acc[ai][bj][m][1] * r;
                        v4u w; w.x = pg8::cvt_pk_bf16(v0[0], v0[1]); w.y = pg8::cvt_pk_bf16(v0[2], v0[3]); w.z = pg8::cvt_pk_bf16(v1[0], v1[1]); w.w = pg8::cvt_pk_bf16(v1[2], v1[3]);
                        *(v4u*)(rowp + bj * 128) = w; }
                    EPI_FENCE(); }
        } else {
#pragma unroll
            for (int ai = 0; ai < 2; ++ai)
#pragma unroll
                for (int m = 0; m < 4; ++m) { const int row = row0 + ai * 128 + m * 16; const float r = row_scale1(ssq, row, fq);
                    if (wc == 0 && fq < 2) { float* rowp = ba + (size_t)row * 16 + 8 * fq; *(f32x4*)(rowp) = acc[ai][0][m][0] * r; *(f32x4*)(rowp + 4) = acc[ai][0][m][1] * r; }
                    EPI_FENCE(); }
        }
    }
};
struct EpiRes {
    static constexpr bool PERM = true;
    bf16* hb; float* ssq;
    __device__ __forceinline__ void operator()(const f32x4 (&acc)[2][2][4][2], const pg8::Unit& u, int wr, int wc, int fr_, int fq_) const {
        int fr = fr_, fq = fq_; asm volatile("" : "+v"(fr), "+v"(fq));
        const int row0 = u.pm * 256 + wr * 64 + fr, col0 = u.pn * 256 + wc * 32 + 8 * fq;
#pragma unroll
        for (int ai = 0; ai < 2; ++ai)
#pragma unroll
            for (int m = 0; m < 4; ++m) { const int row = row0 + ai * 128 + m * 16; bf16* bp = hb + (size_t)row * DM + col0; float sq = 0.f;
#pragma unroll
                for (int bj = 0; bj < 2; ++bj) { const v4u o = *(const v4u*)(bp + bj * 128);
                    f32x4 v0 = acc[ai][bj][m][0], v1 = acc[ai][bj][m][1];
                    v0[0] += __builtin_bit_cast(float, o.x << 16); v0[1] += __builtin_bit_cast(float, o.x & 0xffff0000u); v0[2] += __builtin_bit_cast(float, o.y << 16); v0[3] += __builtin_bit_cast(float, o.y & 0xffff0000u);
                    v1[0] += __builtin_bit_cast(float, o.z << 16); v1[1] += __builtin_bit_cast(float, o.z & 0xffff0000u); v1[2] += __builtin_bit_cast(float, o.w << 16); v1[3] += __builtin_bit_cast(float, o.w & 0xffff0000u);
                    sq += ((v0[0] * v0[0] + v0[1] * v0[1]) + (v0[2] * v0[2] + v0[3] * v0[3])) + ((v1[0] * v1[0] + v1[1] * v1[1]) + (v1[2] * v1[2] + v1[3] * v1[3]));
                    v4u w; w.x = pg8::cvt_pk_bf16(v0[0], v0[1]); w.y = pg8::cvt_pk_bf16(v0[2], v0[3]); w.z = pg8::cvt_pk_bf16(v1[0], v1[1]); w.w = pg8::cvt_pk_bf16(v1[2], v1[3]);
                    *(v4u*)(bp + bj * 128) = w; }
                sq += __shfl_xor(sq, 16); sq += __shfl_xor(sq, 32);
                if (fq == 0) ssq[(size_t)row * 32 + u.pn * 4 + wc] = sq;
                EPI_FENCE(); }
    }
};
struct EpiSwiGLU {
    static constexpr bool PERM = true;
    bf16* act; const float* ssq;
    __device__ __forceinline__ void operator()(const f32x4 (&acc)[2][2][4][2], const pg8::Unit& u, int wr, int wc, int fr_, int fq_) const {
        int fr = fr_, fq = fq_; asm volatile("" : "+v"(fr), "+v"(fq));
        const int row0 = u.pm * 256 + wr * 64 + fr, col0 = u.pn * 128 + wc * 32 + 8 * fq;
#pragma unroll
        for (int ai = 0; ai < 2; ++ai)
#pragma unroll
            for (int m = 0; m < 4; ++m) { const int row = row0 + ai * 128 + m * 16; const float r = row_scale1(ssq, row, fq); v4u w;
#pragma unroll
                for (int n = 0; n < 2; ++n) { const f32x4 gt = acc[ai][0][m][n] * r, up = acc[ai][1][m][n] * r;
                    const float o0 = silu_f(gt[0]) * up[0], o1 = silu_f(gt[1]) * up[1], o2 = silu_f(gt[2]) * up[2], o3 = silu_f(gt[3]) * up[3];
                    const unsigned lo = pg8::cvt_pk_bf16(o0, o1), hi = pg8::cvt_pk_bf16(o2, o3);
                    if (n == 0) { w.x = lo; w.y = hi; } else { w.z = lo; w.w = hi; } }
                *(v4u*)(act + (size_t)row * DFF + col0) = w;
                EPI_FENCE(); }
    }
};
struct EpiPool {
    static constexpr bool PERM = true;
    bf16* cat; const float* scale;
    __device__ __forceinline__ void operator()(const f32x4 (&acc)[2][2][4][2], const pg8::Unit& u, int wr, int wc, int fr_, int fq_) const {
        int fr = fr_, fq = fq_; asm volatile("" : "+v"(fr), "+v"(fq));
        const int row0 = u.pm * 256 + wr * 64 + fr, col0 = u.pn * 256 + wc * 32 + 8 * fq;
#pragma unroll
        for (int bj = 0; bj < 2; ++bj) { const f32x4 s0 = *(const f32x4*)(scale + col0 + bj * 128), s1 = *(const f32x4*)(scale + col0 + bj * 128 + 4);
#pragma unroll
            for (int ai = 0; ai < 2; ++ai)
#pragma unroll
                for (int m = 0; m < 4; ++m) { bf16* rowp = cat + (size_t)(row0 + ai * 128 + m * 16) * DM + DNW + col0;
                    const f32x4 v0 = acc[ai][bj][m][0] * s0, v1 = acc[ai][bj][m][1] * s1;
                    v4u w; w.x = pg8::cvt_pk_bf16(v0[0], v0[1]); w.y = pg8::cvt_pk_bf16(v0[2], v0[3]); w.z = pg8::cvt_pk_bf16(v1[0], v1[1]); w.w = pg8::cvt_pk_bf16(v1[2], v1[3]);
                    *(v4u*)(rowp + bj * 128) = w; }
            EPI_FENCE(); }
    }
};

struct MixP {
    const bf16* proj; const float* ba; bf16* cat; const float *conv_w, *a_log, *dt_bias, *dn_norm;
};
__device__ __forceinline__ void delta_seq(LAS unsigned char* lds, const MixP& P, int row_base, int ntok_total, int h, const float* S0, const float* cstate  , float* Sout) {
    LAS float* qs = (LAS float*)lds; LAS float* ks = qs + 64 * 128; LAS float* vs = ks + 64 * 128; LAS float* os = vs + 64 * 128;
    LAS float* bt = os + 64 * 128; LAS float* egs = bt + 64;
    int tid_ = threadIdx.x; asm volatile("" : "+v"(tid_));
    const int tid = tid_, lane = tid & 63, wave = tid >> 6, vcol = tid >> 2, kq = tid & 3;
    float S[32];
#pragma unroll
    for (int i = 0; i < 32; ++i) S[i] = S0 ? S0[(size_t)(32 * kq + i) * 128 + vcol] : 0.f;
    const float Ah = __expf(P.a_log[h]), dtb = P.dt_bias[h];
    for (int t0 = 0; t0 < ntok_total; t0 += 64) {
        const int nt = (ntok_total - t0) < 64 ? (ntok_total - t0) : 64;
        for (int idx = tid; idx < nt * 384; idx += NTHR) {
            const int t = idx / 384, c = idx - t * 384, part = c >> 7, cc = c & 127, col = part * 1024 + h * 128 + cc; float y = 0.f;
#pragma unroll
            for (int i = 0; i < 4; ++i) { const int tt = t0 + t - 3 + i; float pv;
                if (tt >= 0) pv = bf2f(P.proj[(size_t)(row_base + tt) * PROJ_LD + col]); else pv = cstate ? cstate[(3 + tt) * 3072 + col] : 0.f;
                y += pv * P.conv_w[i * 3072 + col]; }
            y = silu_f(y);
            (part == 0 ? qs : (part == 1 ? ks : vs))[t * 128 + cc] = y;
        }
        if (tid < nt) { const int row = row_base + t0 + tid; const float braw = P.ba[(size_t)row * 16 + h], araw = P.ba[(size_t)row * 16 + 8 + h];
            bt[tid] = sigmoid_f(braw); egs[tid] = __expf(-Ah * softplus_f(araw + dtb)); }
        __syncthreads();
        for (int pr = wave; pr < 2 * nt; pr += NWAVES) { const int t = pr >> 1; LAS float* p = (pr & 1) ? ks : qs; const float a = p[t * 128 + lane], b = p[t * 128 + 64 + lane];
            const float ss = wave_sum(a * a + b * b); float sc = rsqrt_f(ss + EPS); if (!(pr & 1)) sc *= 0.08838834764831845f;
            p[t * 128 + lane] = a * sc; p[t * 128 + 64 + lane] = b * sc; }
        __syncthreads();
        for (int t = 0; t < nt; ++t) {
            const float eg = egs[t], beta = bt[t], vv = vs[t * 128 + vcol];
            const LAS f32x4* kp = (const LAS f32x4*)(ks + t * 128 + 32 * kq); const LAS f32x4* qp = (const LAS f32x4*)(qs + t * 128 + 32 * kq);
            float kr[32]; float kv = 0.f;
#pragma unroll
            for (int i = 0; i < 8; ++i) { const f32x4 k4 = kp[i]; kr[4 * i] = k4[0]; kr[4 * i + 1] = k4[1]; kr[4 * i + 2] = k4[2]; kr[4 * i + 3] = k4[3]; }
#pragma unroll
            for (int i = 0; i < 32; ++i) { S[i] *= eg; kv += kr[i] * S[i]; }
            kv += __shfl_xor(kv, 1); kv += __shfl_xor(kv, 2);
            const float dl = (vv - kv) * beta; float o = 0.f;
#pragma unroll
            for (int i = 0; i < 8; ++i) { const f32x4 q4 = qp[i];
                S[4 * i] += kr[4 * i] * dl; S[4 * i + 1] += kr[4 * i + 1] * dl; S[4 * i + 2] += kr[4 * i + 2] * dl; S[4 * i + 3] += kr[4 * i + 3] * dl;
                o += q4[0] * S[4 * i] + q4[1] * S[4 * i + 1] + q4[2] * S[4 * i + 2] + q4[3] * S[4 * i + 3]; }
            o += __shfl_xor(o, 1); o += __shfl_xor(o, 2);
            if (kq == 0) os[t * 128 + vcol] = o;
        }
        __syncthreads();
        for (int t = wave; t < nt; t += NWAVES) { const int row = row_base + t0 + t; const float a = os[t * 128 + lane], b = os[t * 128 + 64 + lane];
            const float ss = wave_sum(a * a + b * b); const float rs = rsqrt_f(ss * (1.0f / 128.f) + EPS);
            const float za = bf2f(P.proj[(size_t)row * PROJ_LD + 3072 + h * 128 + lane]), zb = bf2f(P.proj[(size_t)row * PROJ_LD + 3072 + h * 128 + 64 + lane]);
            P.cat[(size_t)row * DM + h * 128 + lane] = (bf16)f2bf(a * rs * P.dn_norm[lane] * silu_f(za));
            P.cat[(size_t)row * DM + h * 128 + 64 + lane] = (bf16)f2bf(b * rs * P.dn_norm[64 + lane] * silu_f(zb)); }
        __syncthreads();
    }
#pragma unroll
    for (int i = 0; i < 32; ++i) Sout[(size_t)(32 * kq + i) * 128 + vcol] = S[i];
}


typedef short bf16x8 __attribute__((ext_vector_type(8)));
#define BAR_LDS() do { asm volatile("s_waitcnt lgkmcnt(0)" ::: "memory"); __builtin_amdgcn_s_barrier(); asm volatile("" ::: "memory"); } while (0)
__device__ __forceinline__ bf16x8 frag_lds(const LAS bf16* base, int ld, int row0, int k0, int lane) { return *(const LAS bf16x8*)(base + (row0 + (lane & 15)) * ld + k0 + 8 * (lane >> 4)); }
__device__ __forceinline__ bf16x8 frag_glb(const bf16* base, int ld, int row0, int k0, int lane) { return *(const bf16x8*)(base + (size_t)(row0 + (lane & 15)) * ld + k0 + 8 * (lane >> 4)); }
#define MMA16(a, b, c) __builtin_amdgcn_mfma_f32_16x16x32_bf16((a), (b), (c), 0, 0, 0)
constexpr int PLD = 136;
constexpr int MLD = 68;
struct PrepP { const bf16* proj; const float* ba; const float *conv_w, *a_log, *dt_bias; bf16 *dW, *dQG, *dQK, *dKD; float *dU, *dEGL; };
constexpr int PREP_LDS = 71680;
__device__ __forceinline__ float rdlane(float v, int l) { return __builtin_bit_cast(float, __builtin_amdgcn_readlane(__builtin_bit_cast(int, v), l)); }
__device__ __forceinline__ void prep_pair(LAS unsigned char* lds, const PrepP& P, int u0, int u1) {
    int tid_ = threadIdx.x; asm volatile("" : "+v"(tid_));
    const int tid = tid_, lane = tid & 63, wave = __builtin_amdgcn_readfirstlane(tid >> 6), g = wave >> 2, lw = wave & 3, lt = tid & 255;
    { unsigned lb_ = (unsigned)(size_t)lds + (unsigned)g * PREP_LDS; asm volatile("" : "+v"(lb_)); lds = (LAS unsigned char*)(size_t)lb_; }
    LAS bf16* Qr = (LAS bf16*)lds;
    LAS bf16* Kr = Qr + 64 * PLD;
    LAS float* Mf = (LAS float*)(Kr + 64 * PLD);
    LAS float* ssk = Mf + 64 * MLD; LAS float* ssq = ssk + 64;
    LAS float* rkv = ssq + 64; LAS float* rqv = rkv + 64;
    LAS float* sbeta = rqv + 64; LAS float* sgc = sbeta + 64; LAS float* segc = sgc + 64; LAS float* sekd = segc + 64;
    const int u = g ? u1 : u0, c = u & 31, bh = u >> 5, b = bh >> 3, h = bh & 7, row0 = b * SEQ + c * 64;
    const bool isk = lt < 128; const int cc = lt & 127, th = lt >> 7;
    float x[64], xq[32];
    if (lw == 3) {
        const float Ah = __expf(P.a_log[h]), dtb = P.dt_bias[h];
        const float braw = P.ba[(size_t)(row0 + lane) * 16 + h], araw = P.ba[(size_t)(row0 + lane) * 16 + 8 + h];
        const float beta = sigmoid_f(braw), gg = -Ah * softplus_f(araw + dtb);
        float gc = gg;
#pragma unroll
        for (int o = 1; o < 64; o <<= 1) { const float v = __shfl_up(gc, o); if (lane >= o) gc += v; }
        const float gl = __shfl(gc, 63);
        sbeta[lane] = beta; sgc[lane] = gc; segc[lane] = __expf(gc); sekd[lane] = __expf(gl - gc);
        if (lane == 0) P.dEGL[u] = __expf(gl);
    }
    {
        const int col = (isk ? 1024 : 2048) + h * 128 + cc;
        const float w0 = P.conv_w[col], w1 = P.conv_w[3072 + col], w2 = P.conv_w[2 * 3072 + col], w3 = P.conv_w[3 * 3072 + col];
        const bf16* pp = P.proj + (size_t)row0 * PROJ_LD + col;
        float pm3 = 0.f, pm2 = 0.f, pm1 = 0.f;
        if (c > 0) { pm3 = bf2f(pp[-3 * PROJ_LD]); pm2 = bf2f(pp[-2 * PROJ_LD]); pm1 = bf2f(pp[-1 * PROJ_LD]); }
#pragma unroll
        for (int t = 0; t < 64; ++t) { const float pc = bf2f(pp[(size_t)t * PROJ_LD]); x[t] = silu_f(w0 * pm3 + w1 * pm2 + w2 * pm1 + w3 * pc); pm3 = pm2; pm2 = pm1; pm1 = pc; }
        if (isk) {
#pragma unroll
            for (int t = 0; t < 64; ++t) Kr[t * PLD + cc] = (bf16)f2bf(x[t]); }
    }
    {
        const int col = h * 128 + cc;
        const float w0 = P.conv_w[col], w1 = P.conv_w[3072 + col], w2 = P.conv_w[2 * 3072 + col], w3 = P.conv_w[3 * 3072 + col];
        const bf16* pp = P.proj + (size_t)(row0 + 32 * th) * PROJ_LD + col;
        float pm3 = 0.f, pm2 = 0.f, pm1 = 0.f;
        if (c > 0 || th > 0) { pm3 = bf2f(pp[-3 * PROJ_LD]); pm2 = bf2f(pp[-2 * PROJ_LD]); pm1 = bf2f(pp[-1 * PROJ_LD]); }
#pragma unroll
        for (int t = 0; t < 32; ++t) { const float pc = bf2f(pp[(size_t)t * PROJ_LD]); xq[t] = silu_f(w0 * pm3 + w1 * pm2 + w2 * pm1 + w3 * pc); pm3 = pm2; pm2 = pm1; pm1 = pc;
            Qr[(32 * th + t) * PLD + cc] = (bf16)f2bf(xq[t]); }
    }
    BAR_LDS();
    const int fr = lane & 15, fq = lane >> 4;
    f32x4 tacc[6];
#pragma unroll
    for (int n = 0; n < 6; ++n) {
        const int e = lw * 6 + n, ty = e < 10 ? 0 : (e < 20 ? 1 : 2), pidx = ty == 0 ? e : (ty == 1 ? e - 10 : 0);
        const int ti = ty == 2 ? e - 20 : (pidx >= 6 ? 3 : (pidx >= 3 ? 2 : (pidx >= 1 ? 1 : 0))), tj = ty == 2 ? ti : pidx - ti * (ti + 1) / 2;
        const LAS bf16* Xa = ty == 0 ? Kr : Qr; const LAS bf16* Xb = ty == 2 ? Qr : Kr;
        f32x4 acc = (f32x4){0.f, 0.f, 0.f, 0.f};
#pragma unroll
        for (int ks = 0; ks < 4; ++ks) acc = MMA16(frag_lds(Xb, PLD, 16 * tj, 32 * ks, lane), frag_lds(Xa, PLD, 16 * ti, 32 * ks, lane), acc);
        tacc[n] = acc;
        if (ti == tj && ty != 1 && (fr >> 2) == fq) { const int jj = fr & 3; const float d = jj == 0 ? acc[0] : (jj == 1 ? acc[1] : (jj == 2 ? acc[2] : acc[3])); (ty == 0 ? ssk : ssq)[16 * ti + fr] = d; }
    }
    BAR_LDS();
    const float rk_l = rsqrt_f(ssk[lane] + EPS), rq_l = rsqrt_f(ssq[lane] + EPS) * 0.08838834764831845f, bet_l = sbeta[lane], egc_l = segc[lane];
    const float cq_l = rq_l * egc_l, ckd_l = rk_l * sekd[lane], ckb_l = rk_l * bet_l * egc_l;
    rkv[lane] = rk_l; rqv[lane] = rq_l;
    asm volatile("s_waitcnt lgkmcnt(0)" ::: "memory");
#pragma unroll
    for (int n = 0; n < 6; ++n) {
        const int e = lw * 6 + n, ty = e < 10 ? 0 : (e < 20 ? 1 : 2), pidx = ty == 0 ? e : (ty == 1 ? e - 10 : 0);
        const int ti = ty == 2 ? e - 20 : (pidx >= 6 ? 3 : (pidx >= 3 ? 2 : (pidx >= 1 ? 1 : 0))), tj = ty == 2 ? ti : pidx - ti * (ti + 1) / 2;
        if (ty < 2) {
            const int i = 16 * ti + fr, j0 = 16 * tj + 4 * fq; const float gi = sgc[i]; const float pre = ty == 0 ? sbeta[i] * rkv[i] : rqv[i];
            const f32x4 rj = *(const LAS f32x4*)(rkv + j0), gj = *(const LAS f32x4*)(sgc + j0);
            float o[4];
#pragma unroll
            for (int jj = 0; jj < 4; ++jj) { const int j = j0 + jj; const float dec = __expf(gi - gj[jj]); const bool keep = ty ? (i >= j) : (i > j); o[jj] = keep ? tacc[n][jj] * pre * rj[jj] * dec : 0.f; }
            if (ty) { v2u w; w.x = pk2(o[0], o[1]); w.y = pk2(o[2], o[3]); *(v2u*)(P.dQK + (size_t)u * 4096 + ((ti * 2 + (tj >> 1)) * 64 + ((2 * tj + (fq >> 1)) & 3) * 16 + fr) * 8 + 4 * (fq & 1)) = w; }
            else *(LAS f32x4*)(Mf + i * MLD + j0) = (f32x4){o[0], o[1], o[2], o[3]};
        }
    }
    {
#pragma unroll
        for (int n = 0; n < 3; ++n) { const int z = lw * 3 + n, ty = z / 6, p6 = z % 6;
            const int ti = p6 < 3 ? 0 : (p6 < 5 ? 1 : 2), tj = p6 < 3 ? p6 + 1 : (p6 < 5 ? p6 - 1 : 3);
            const int i = 16 * ti + fr, j0 = 16 * tj + 4 * fq;
            if (ty) { v2u w; w.x = 0u; w.y = 0u; *(v2u*)(P.dQK + (size_t)u * 4096 + ((ti * 2 + (tj >> 1)) * 64 + ((2 * tj + (fq >> 1)) & 3) * 16 + fr) * 8 + 4 * (fq & 1)) = w; }
            else *(LAS f32x4*)(Mf + i * MLD + j0) = (f32x4){0.f, 0.f, 0.f, 0.f}; }
    }
    if (isk) {
        bf16* kd = P.dKD + (size_t)u * 8192 + (size_t)(cc >> 4) * 1024 + (cc & 15) * 8;
        unsigned pk[32];
#pragma unroll
        for (int t = 0; t < 64; ++t) { const unsigned kdv = f2bf(x[t] * rdlane(ckd_l, t)); if (t & 1) pk[t >> 1] |= kdv << 16; else pk[t >> 1] = kdv; x[t] *= rdlane(ckb_l, t); }
#pragma unroll
        for (int i = 0; i < 8; ++i) { v4u o; o.x = pk[4 * i]; o.y = pk[4 * i + 1]; o.z = pk[4 * i + 2]; o.w = pk[4 * i + 3]; *(v4u*)(kd + (i >> 2) * 512 + (i & 3) * 128) = o; }
    } else {
#pragma unroll
        for (int t = 0; t < 64; ++t) x[t] *= rdlane(bet_l, t);
    }
    BAR_LDS();
#pragma unroll
    for (int i = 1; i < 64; ++i) { float a0 = x[i], a1 = 0.f, a2 = 0.f, a3 = 0.f;
#pragma unroll
        for (int jg = 0; 4 * jg < i; ++jg) { const f32x4 m = *(const LAS f32x4*)(Mf + i * MLD + 4 * jg);
            a0 -= m[0] * x[4 * jg]; a1 -= m[1] * x[4 * jg + 1]; a2 -= m[2] * x[4 * jg + 2]; a3 -= m[3] * x[4 * jg + 3]; }
        x[i] = (a0 + a1) + (a2 + a3); }
    if (isk) {
#pragma unroll
        for (int t = 0; t < 64; ++t) Kr[t * PLD + cc] = (bf16)f2bf(x[t]);
    } else { float* up = P.dU + (size_t)u * 8192 + (size_t)(cc >> 4) * 1024 + (cc & 15) * 4;
#pragma unroll
        for (int i = 0; i < 16; ++i) *(f32x4*)(up + (i >> 2) * 256 + (i & 3) * 64) = (f32x4){x[4 * i], x[4 * i + 1], x[4 * i + 2], x[4 * i + 3]}; }
#pragma unroll
    for (int t = 0; t < 32; ++t) { const int tt = 32 * th + t; Qr[tt * PLD + cc] = (bf16)f2bf(xq[t] * rdlane(cq_l, tt)); }
    BAR_LDS();
#pragma unroll
    for (int i = 0; i < 4; ++i) { const int pz = (lw * 4 + i) * 64 + lane; const int rb = pz >> 8, ks = (pz >> 6) & 3, t = rb * 16 + (lane & 15), d0 = ks * 32 + (lane >> 4) * 8;
        *(v4u*)(P.dW + (size_t)u * 8192 + (size_t)pz * 8) = *(const LAS v4u*)(Kr + t * PLD + d0);
        *(v4u*)(P.dQG + (size_t)u * 8192 + (size_t)pz * 8) = *(const LAS v4u*)(Qr + t * PLD + d0); }
    BAR_LDS();
}
struct ScanP { const bf16 *dW, *dQG, *dQK, *dKD; const float *dU, *dEGL; float *ob, *ossq, *sout; };
constexpr int VLD = 72;
template <bool LOW>
__device__ __forceinline__ void scan_loop(LAS bf16* St, LAS bf16* Vt, const ScanP& P, int bh, int sl, int wave, int lane, f32x4& S) {
    const int fr = lane & 15, fq = lane >> 4, rb = wave & 3, e0 = sl * 16, b = bh / NH, h = bh % NH;
    const size_t u0 = (size_t)bh * (SEQ / 64);
    struct Ops { bf16x8 A1[4], K2[2], QK[2]; f32x4 Uv; float egl; };
    Ops R0, R1, R2, R3;
#define SCAN_LOAD(o, cc) do { const size_t u_ = u0 + ((cc) < SEQ / 64 ? (cc) : SEQ / 64 - 1); const bf16* a1 = (LOW ? P.dW : P.dQG) + u_ * 8192; \
        _Pragma("unroll") for (int ks = 0; ks < 4; ++ks) (o).A1[ks] = *(const bf16x8*)(a1 + ((rb * 4 + ks) * 64 + lane) * 8); \
        _Pragma("unroll") for (int ks = 0; ks < 2; ++ks) (o).K2[ks] = *(const bf16x8*)(P.dKD + u_ * 8192 + ((wave * 2 + ks) * 64 + lane) * 8); \
        if (LOW) (o).Uv = *(const f32x4*)(P.dU + u_ * 8192 + ((sl * 4 + rb) * 64 + lane) * 4); \
        else { _Pragma("unroll") for (int ks = 0; ks < 2; ++ks) (o).QK[ks] = *(const bf16x8*)(P.dQK + u_ * 4096 + ((rb * 2 + ks) * 64 + lane) * 8); } \
        (o).egl = P.dEGL[u_]; } while (0)
#define SCAN_STEP(cur, nxt, c) do { SCAN_LOAD(nxt, (c) + 3); \
        f32x4 acc = (f32x4){0.f, 0.f, 0.f, 0.f}; \
        _Pragma("unroll") for (int ks = 0; ks < 4; ++ks) acc = MMA16((cur).A1[ks], frag_lds(St, PLD, 0, 32 * ks, lane), acc); \
        if (LOW) { const f32x4 vn = (cur).Uv - acc; v2u w; w.x = pk2(vn[0], vn[1]); w.y = pk2(vn[2], vn[3]); *(LAS v2u*)(Vt + fr * VLD + 16 * rb + 4 * fq) = w; } \
        BAR_LDS(); \
        const bf16x8 v0 = frag_lds(Vt, VLD, 0, 0, lane), v1 = frag_lds(Vt, VLD, 0, 32, lane); \
        if (!LOW) { acc = MMA16((cur).QK[0], v0, acc); acc = MMA16((cur).QK[1], v1, acc); \
            const int row = b * SEQ + (c) * 64 + 16 * rb + 4 * fq; float* op = P.ob + (size_t)row * DNW + h * 128 + e0 + fr; \
            _Pragma("unroll") for (int j = 0; j < 4; ++j) __hip_atomic_store(op + (size_t)j * DNW, acc[j], __ATOMIC_RELAXED, __HIP_MEMORY_SCOPE_AGENT); }     \
        S = S * (cur).egl; S = MMA16((cur).K2[0], v0, S); S = MMA16((cur).K2[1], v1, S); \
        { v2u w; w.x = pk2(S[0], S[1]); w.y = pk2(S[2], S[3]); *(LAS v2u*)(St + fr * PLD + 16 * wave + 4 * fq) = w; } \
        BAR_LDS(); } while (0)
    SCAN_LOAD(R0, 0); SCAN_LOAD(R1, 1); SCAN_LOAD(R2, 2);
    for (int c0 = 0; c0 < SEQ / 64; c0 += 4) { SCAN_STEP(R0, R3, c0); SCAN_STEP(R1, R0, c0 + 1); SCAN_STEP(R2, R1, c0 + 2); SCAN_STEP(R3, R2, c0 + 3); }
#undef SCAN_STEP
#undef SCAN_LOAD
}
__device__ __forceinline__ void scan_item(LAS unsigned char* lds, const ScanP& P, int bh, int sl) {
    LAS bf16* St = (LAS bf16*)lds;
    LAS bf16* Vt = St + 16 * PLD;
    int tid_ = threadIdx.x; asm volatile("" : "+v"(tid_));
    const int tid = tid_, lane = tid & 63, wave = __builtin_amdgcn_readfirstlane(tid >> 6), fr = lane & 15, fq = lane >> 4;
    for (int i = tid; i < 16 * PLD / 2; i += NTHR) ((LAS unsigned*)St)[i] = 0u;
    f32x4 S = (f32x4){0.f, 0.f, 0.f, 0.f};
    BAR_LDS();
    if (wave < 4) scan_loop<true>(St, Vt, P, bh, sl, wave, lane, S); else scan_loop<false>(St, Vt, P, bh, sl, wave, lane, S);
    float* so = P.sout + (size_t)bh * 16384 + (size_t)(16 * wave + 4 * fq) * 128 + sl * 16 + fr;
#pragma unroll
    for (int j = 0; j < 4; ++j) so[j * 128] = S[j];
}

constexpr int SK_SLOT = 20480;
__device__ __forceinline__ void skinny2_mma(LAS unsigned char* lds, const bf16* A, int lda, const bf16* Bt, int ldb, int K, int brow0, int brow1, f32x4 (&acc)[2]) {
    int tid_ = threadIdx.x; asm volatile("" : "+v"(tid_));
    const int tid = tid_, lane = tid & 63, wave = __builtin_amdgcn_readfirstlane(tid >> 6), fr = lane & 15, fq = lane >> 4;
    unsigned voffA[2], voffB;
#pragma unroll
    for (int i = 0; i < 2; ++i) { int R, C; pg8::stage_rc(tid * 16 + i * 8192, R, C); voffA[i] = (unsigned)(R * lda + C) * 2u; }
    { int R, C; pg8::stage_rc((tid & 255) * 16, R, C); voffB = (unsigned)((R < 16 ? brow0 + R : brow1 + R - 16) * ldb + C) * 2u; }
    const unsigned ldswA = (unsigned)wave * 1024u, ldswB = 16384u + (unsigned)(wave & 3) * 1024u;
    int aoff[2], boff[2][2];
#pragma unroll
    for (int ks = 0; ks < 2; ++ks) { aoff[ks] = pg8::lds_byte(16 * wave + fr, 32 * ks + 8 * fq); boff[0][ks] = 16384 + pg8::lds_byte(fr, 32 * ks + 8 * fq); boff[1][ks] = 16384 + pg8::lds_byte(16 + fr, 32 * ks + 8 * fq); }
    const int nt = K / 64;
#define SK_STAGE(kt_, slot_) do { const char* ga = (const char*)A + (size_t)(kt_) * 128; const char* gb = (const char*)Bt + (size_t)(kt_) * 128; LAS unsigned char* sl_ = lds + (slot_) * SK_SLOT; \
        _Pragma("unroll") for (int _i = 0; _i < 2; ++_i) { unsigned vo = voffA[_i]; asm volatile("" : "+v"(vo)); __builtin_amdgcn_global_load_lds((const unsigned*)(ga + vo), (LAS unsigned*)(sl_ + ldswA + _i * 8192), 16, 0, 0); } \
        { unsigned vo = voffB; asm volatile("" : "+v"(vo)); __builtin_amdgcn_global_load_lds((const unsigned*)(gb + vo), (LAS unsigned*)(sl_ + ldswB), 16, 0, 0); } } while (0)
    acc[0] = (f32x4){0.f, 0.f, 0.f, 0.f}; acc[1] = (f32x4){0.f, 0.f, 0.f, 0.f};
    SK_STAGE(0, 0); SK_STAGE(1, 1); SK_STAGE(2, 2);
    for (int kt = 0; kt < nt; ++kt) {
        asm volatile("s_waitcnt vmcnt(6)" ::: "memory");
        __builtin_amdgcn_s_barrier(); asm volatile("" ::: "memory");
        { const int k3 = kt + 3 < nt ? kt + 3 : 0; SK_STAGE(k3, (kt + 3) & 3); }
        const LAS unsigned char* sl = lds + (kt & 3) * SK_SLOT;
#pragma unroll
        for (int ks = 0; ks < 2; ++ks) { const bf16x8 a = *(const LAS bf16x8*)(sl + aoff[ks]), b0 = *(const LAS bf16x8*)(sl + boff[0][ks]), b1 = *(const LAS bf16x8*)(sl + boff[1][ks]);
            acc[0] = MMA16(b0, a, acc[0]); acc[1] = MMA16(b1, a, acc[1]); }
        asm volatile("s_waitcnt lgkmcnt(0)" ::: "memory");
    }
    asm volatile("s_waitcnt vmcnt(0)" ::: "memory");
    __builtin_amdgcn_s_barrier(); asm volatile("" ::: "memory");
#undef SK_STAGE
}
__device__ __forceinline__ void short_blocks(int nwg, int G, int c, int& si, int& nshort) {
    const int rounds = (nwg + G - 1) / G, full = nwg - (rounds - 1) * G;
    if (full == G) { nshort = G; si = c; } else { nshort = G - full; si = c - full; }
}
__device__ __forceinline__ float dec_row_scale(const float* dssq, int r) {
    const f32x4* p = (const f32x4*)(dssq + (size_t)r * 64); float s = 0.f;
#pragma unroll
    for (int i = 0; i < 16; ++i) { const f32x4 v = p[i]; s += (v[0] + v[1]) + (v[2] + v[3]); }
    return rsqrt_f(s * (1.0f / DM) + EPS);
}
constexpr int SK8_SLOT = 32768;
template <bool GU>
__device__ __forceinline__ void skinny128_mma(LAS unsigned char* lds, const bf16* A, int lda, const bf16* Bt, int ldb, int K, int brow0, f32x4 (&acc)[8]) {
    int tid_ = threadIdx.x; asm volatile("" : "+v"(tid_));
    const int tid = tid_, lane = tid & 63, wave = __builtin_amdgcn_readfirstlane(tid >> 6), fr = lane & 15, fq = lane >> 4;
    unsigned voffA[2], voffB[2];
#pragma unroll
    for (int i = 0; i < 2; ++i) { int R, C; pg8::stage_rc(tid * 16 + i * 8192, R, C); voffA[i] = (unsigned)(R * lda + C) * 2u;
        const int rowb = GU ? (R < 64 ? brow0 + R : brow0 + 128 + (R - 64)) : brow0 + R; voffB[i] = (unsigned)(rowb * ldb + C) * 2u; }
    const unsigned ldsw = (unsigned)wave * 1024u;
    int aoff[2], boff[2];
#pragma unroll
    for (int ks = 0; ks < 2; ++ks) { aoff[ks] = pg8::lds_byte(16 * wave + fr, 32 * ks + 8 * fq); boff[ks] = 16384 + pg8::lds_byte(fr, 32 * ks + 8 * fq); }
    const int nt = K / 64;
#define SK8_STAGE(kt_, slot_) do { const char* ga = (const char*)A + (size_t)(kt_) * 128; const char* gb = (const char*)Bt + (size_t)(kt_) * 128; LAS unsigned char* sl_ = lds + (slot_) * SK8_SLOT; \
        _Pragma("unroll") for (int _i = 0; _i < 2; ++_i) { unsigned vo = voffA[_i]; asm volatile("" : "+v"(vo)); __builtin_amdgcn_global_load_lds((const unsigned*)(ga + vo), (LAS unsigned*)(sl_ + ldsw + _i * 8192), 16, 0, 0); } \
        _Pragma("unroll") for (int _i = 0; _i < 2; ++_i) { unsigned vo = voffB[_i]; asm volatile("" : "+v"(vo)); __builtin_amdgcn_global_load_lds((const unsigned*)(gb + vo), (LAS unsigned*)(sl_ + 16384 + ldsw + _i * 8192), 16, 0, 0); } } while (0)
#pragma unroll
    for (int nb = 0; nb < 8; ++nb) acc[nb] = (f32x4){0.f, 0.f, 0.f, 0.f};
    SK8_STAGE(0, 0); SK8_STAGE(1, 1); SK8_STAGE(2, 2);
    for (int kt = 0; kt < nt; ++kt) {
        asm volatile("s_waitcnt vmcnt(8)" ::: "memory");
        __builtin_amdgcn_s_barrier(); asm volatile("" ::: "memory");
        { const int k3 = kt + 3 < nt ? kt + 3 : 0; SK8_STAGE(k3, (kt + 3) & 3); }
        const LAS unsigned char* sl = lds + (kt & 3) * SK8_SLOT;
#pragma unroll
        for (int ks = 0; ks < 2; ++ks) { const bf16x8 a = *(const LAS bf16x8*)(sl + aoff[ks]);
#pragma unroll
            for (int nb = 0; nb < 8; ++nb) { const bf16x8 bq = *(const LAS bf16x8*)(sl + boff[ks] + nb * 2048); acc[nb] = MMA16(bq, a, acc[nb]); } }
        asm volatile("s_waitcnt lgkmcnt(0)" ::: "memory");
    }
    asm volatile("s_waitcnt vmcnt(0)" ::: "memory");
    __builtin_amdgcn_s_barrier(); asm volatile("" ::: "memory");
#undef SK8_STAGE
}
__device__ __forceinline__ void dec_in_tiles(LAS unsigned char* lds, const bf16* HB, const bf16* Bt, bf16* proj, float* ba, const float* dssq, int si, int nshort) {
    if (si < 0) return;
    int tl = threadIdx.x; asm volatile("" : "+v"(tl)); const int lane = tl & 63, wave = __builtin_amdgcn_readfirstlane(tl >> 6), r = 16 * wave + (lane & 15), q = lane >> 4;
    for (int t = si; t < 41; t += nshort) {
        f32x4 acc[8];
        skinny128_mma<false>(lds, HB + (size_t)MP * DM, DM, Bt, DM, DM, 128 * t, acc);
        const float rs = dec_row_scale(dssq, r);
        if (t < 40) {
#pragma unroll
            for (int nb = 0; nb < 8; ++nb) { const f32x4 v = acc[nb] * rs; v2u w; w.x = pk2(v[0], v[1]); w.y = pk2(v[2], v[3]); *(v2u*)(proj + (size_t)(MP + r) * PROJ_LD + 128 * t + 16 * nb + 4 * q) = w; }
        } else *(f32x4*)(ba + (size_t)(MP + r) * 16 + 4 * q) = acc[0] * rs;
    }
}
__device__ __forceinline__ void dec_res_tiles(LAS unsigned char* lds, const bf16* A, int K, const bf16* Bt, bf16* hb, float* dssq, int si, int nshort) {
    if (si < 0) return;
    int tl = threadIdx.x; asm volatile("" : "+v"(tl)); const int lane = tl & 63, wave = __builtin_amdgcn_readfirstlane(tl >> 6), r = 16 * wave + (lane & 15), q = lane >> 4;
    for (int t = si; t < 64; t += nshort) {
        f32x4 acc[2];
        skinny2_mma(lds, A + (size_t)MP * K, K, Bt, K, K, 32 * t, 32 * t + 16, acc);
        float sq = 0.f;
#pragma unroll
        for (int nb = 0; nb < 2; ++nb) { bf16* hp = hb + (size_t)(MP + r) * DM + 32 * t + 16 * nb + 4 * q; const v2u o = *(const v2u*)hp; f32x4 v = acc[nb];
            v[0] += __builtin_bit_cast(float, o.x << 16); v[1] += __builtin_bit_cast(float, o.x & 0xffff0000u); v[2] += __builtin_bit_cast(float, o.y << 16); v[3] += __builtin_bit_cast(float, o.y & 0xffff0000u);
            v2u w; w.x = pk2(v[0], v[1]); w.y = pk2(v[2], v[3]); *(v2u*)hp = w;
            sq += (v[0] * v[0] + v[1] * v[1]) + (v[2] * v[2] + v[3] * v[3]); }
        sq += __shfl_xor(sq, 16); sq += __shfl_xor(sq, 32);
        if (q == 0) dssq[(size_t)r * 64 + t] = sq;
    }
}
__device__ __forceinline__ void dec_gu_tiles(LAS unsigned char* lds, const bf16* HB, const bf16* Bt, bf16* act, const float* dssq, int si, int nshort) {
    if (si < 0) return;
    int tl = threadIdx.x; asm volatile("" : "+v"(tl)); const int lane = tl & 63, wave = __builtin_amdgcn_readfirstlane(tl >> 6), r = 16 * wave + (lane & 15), q = lane >> 4;
    for (int t = si; t < DFF / 64; t += nshort) {
        const int c0 = 64 * t, g0 = (c0 >> 7) * 256 + (c0 & 127); f32x4 acc[8];
        skinny128_mma<true>(lds, HB + (size_t)MP * DM, DM, Bt, DM, DM, g0, acc);
        const float rs = dec_row_scale(dssq, r);
#pragma unroll
        for (int nb = 0; nb < 4; ++nb) { const f32x4 gt = acc[nb] * rs, up = acc[nb + 4] * rs;
            v2u w; w.x = pk2(silu_f(gt[0]) * up[0], silu_f(gt[1]) * up[1]); w.y = pk2(silu_f(gt[2]) * up[2], silu_f(gt[3]) * up[3]);
            *(v2u*)(act + (size_t)(MP + r) * DFF + c0 + 16 * nb + 4 * q) = w; }
    }
}

#ifndef AL_IN
#define AL_IN true
#define SP_IN true
#define AL_POOL true
#define SP_POOL true
#define AL_RES true
#define SP_RES true
#define AL_GU true
#define SP_GU true
#endif
__device__ __forceinline__ void ph_gemm_in(LAS unsigned char* lds, const bf16* A, const bf16* Bt, bf16* proj, float* ba, const float* ssq, int G, int bid) {
    pg8::Gemm g{A, Bt, MP, NIN, DM, DM, DM, 0}; pg8::StaticOrder S; S.init(MP, NIN, G, bid); EpiIn E{proj, ba, ssq};
    pg8::gemm_phase<EpiIn, pg8::StaticOrder, AL_IN, SP_IN>(lds, g, S, E);
}
__device__ __forceinline__ void ph_gemm_pool(LAS unsigned char* lds, const bf16* A, const bf16* Bt, bf16* cat, const float* scale, int G, int bid) {
    pg8::Gemm g{A, Bt, MPAD, 1024, 256, POOLW, 256, 512}; pg8::StaticOrder S; S.init(MPAD, 1024, G, bid); EpiPool E{cat, scale};
    pg8::gemm_phase<EpiPool, pg8::StaticOrder, AL_POOL, SP_POOL>(lds, g, S, E);
}
__device__ __forceinline__ void ph_gemm_res(LAS unsigned char* lds, const bf16* A, const bf16* Bt, int K, bf16* hb, float* ssq, int G, int bid) {
    pg8::Gemm g{A, Bt, MP, DM, K, K, K, 0}; pg8::StaticOrder S; S.init(MP, DM, G, bid); EpiRes E{hb, ssq};
    pg8::gemm_phase<EpiRes, pg8::StaticOrder, AL_RES, SP_RES>(lds, g, S, E);
}
__device__ __forceinline__ void ph_gemm_gu(LAS unsigned char* lds, const bf16* A, const bf16* Bt, bf16* act, const float* ssq, int G, int bid) {
    pg8::Gemm g{A, Bt, MP, 2 * DFF, DM, DM, DM, 0}; pg8::StaticOrder S; S.init(MP, 2 * DFF, G, bid); EpiSwiGLU E{act, ssq};
    pg8::gemm_phase<EpiSwiGLU, pg8::StaticOrder, AL_GU, SP_GU>(lds, g, S, E);
}

constexpr int N_PHASES = 2 + 6 * DEPTH;
typedef const Args __attribute__((address_space(4)))* KArgs;
__device__ __forceinline__ KArgs kargs_() { KArgs p = (KArgs)__builtin_amdgcn_kernarg_segment_ptr(); asm volatile("" : "+s"(p)); return p; }
#define KA (kargs_())
#define IN(k) (lo <= (k) && (k) < hi)
#define SEAM(k) do { if (IN(k) && IN((k) + 1)) { XcdBarrier bar_; bar_.bar = (unsigned*)(KA->ws + WS_CTL) + CW_BAR; bar_.x = xb_xcc_id(); bar_.st = (volatile LAS unsigned*)(lds + MISC_OFF) + 8; xcd_barrier(bar_); } } while (0)
#define WSP(T, off) ((T*)(ka->ws + (off)))
#define PHASE_PTRS() const KArgs ka = KA; bf16* const WinT = WSP(bf16, WS_WIN); bf16* const WoutT = WSP(bf16, WS_WOUT); bf16* const WguT = WSP(bf16, WS_WGU); bf16* const WdT = WSP(bf16, WS_WD); bf16* const WpT = WSP(bf16, WS_WP); \
    float* const H = WSP(float, WS_H); bf16* const HB = WSP(bf16, WS_HB); bf16* const PROJ = WSP(bf16, WS_PROJ); float* const BA = WSP(float, WS_BA); \
    bf16* const CAT = WSP(bf16, WS_CAT); bf16* const DB = WSP(bf16, WS_DB); bf16* const ACT = WSP(bf16, WS_ACT); float* const SSQ = WSP(float, WS_SSQ); \
    (void)WinT; (void)WoutT; (void)WguT; (void)WdT; (void)WpT; (void)H; (void)HB; (void)PROJ; (void)BA; (void)CAT; (void)DB; (void)ACT; (void)SSQ
template <int l> __device__ __forceinline__ void layer_phases(LAS unsigned char* lds, const int lo, const int hi, const int G, const int bid) {
        const int p0 = 1 + 6 * l;
        if (IN(p0)) {
            PHASE_PTRS();
            ph_gemm_in(lds, HB, WinT + (size_t)l * NIN * DM, PROJ, BA, SSQ, G, bid);
            { int si, ns; short_blocks((MP / 256) * (NIN / 256), G, bid, si, ns); dec_in_tiles(lds, HB, WinT + (size_t)l * NIN * DM, PROJ, BA, WSP(float, WS_DSSQ), si, ns);
              if (l + 1 < DEPTH && G == 256) { const CvP CV{ka->w_in, ka->norm_mix, ka->w_out, ka->w_gate_up, ka->norm_ffn, ka->w_down, ka->w_pool, WinT, WoutT, WguT, WdT, WpT}; convert_tail(CV, lds, l + 1, 0, si, ns, CV_A); } }
        }
        SEAM(p0);
        if (IN(p0 + 1)) {
            PHASE_PTRS();
            {
                PrepP PP{PROJ, BA, ka->conv_w + (size_t)l * 4 * 3072, ka->a_log + l * NH, ka->dt_bias + l * NH, WSP(bf16, WS_DW), WSP(bf16, WS_DQG), WSP(bf16, WS_DQK), WSP(bf16, WS_DKD), WSP(float, WS_DU), WSP(float, WS_EGL)};
                for (int u = bid; u < NUNIT; u += 2 * G) prep_pair(lds, PP, u, u + G < NUNIT ? u + G : u);
            }
            {
                MixP P{PROJ, BA, CAT, ka->conv_w + (size_t)l * 4 * 3072, ka->a_log + l * NH, ka->dt_bias + l * NH, ka->dn_norm + l * HD};
                const int wb = bid, nW = G;
                for (int it = wb; it < DECB * NH; it += nW) { const int b = it / NH, h = it % NH;
                    delta_seq(lds, P, MP + b, 1, h, ka->state_delta + ((size_t)(l * DECB + b) * NH + h) * 16384, ka->state_conv + (size_t)(l * DECB + b) * 3 * 3072, ka->out + O_DS + ((size_t)(l * DECB + b) * NH + h) * 16384); }
                int tl = threadIdx.x; asm volatile("" : "+v"(tl));
                const size_t gt = (size_t)wb * NTHR + tl, gs = (size_t)nW * NTHR;
                for (size_t it = gt; it < (size_t)(MP / 64) * POOLW; it += gs) {
                    const int c = (int)(it & 1023), chunk = (int)(it >> 10), rowb = chunk * 64, t0 = (chunk & 31) * 64, grp = c >> 8;
                    const bf16* pp = PROJ + (size_t)rowb * PROJ_LD + 4096 + c; bf16* dp = DB + (size_t)rowb * POOLW + c;
                    float w[16];
                    w[0] = 0.f;
#pragma unroll
                    for (int j = 0; j < 15; ++j) w[j + 1] = (t0 > 0) ? bf2f(pp[(long)(j - 15) * PROJ_LD]) : 0.f;
#pragma unroll
                    for (int t = 0; t < 64; ++t) {
                        w[t & 15] = bf2f(pp[(size_t)t * PROJ_LD]);
                        const float s2 = w[t & 15] + w[(t - 1) & 15];
                        const float s4 = s2 + (w[(t - 2) & 15] + w[(t - 3) & 15]);
                        const float s8 = s4 + ((w[(t - 4) & 15] + w[(t - 5) & 15]) + (w[(t - 6) & 15] + w[(t - 7) & 15]));
                        const float s16 = s8 + (((w[(t - 8) & 15] + w[(t - 9) & 15]) + (w[(t - 10) & 15] + w[(t - 11) & 15])) + ((w[(t - 12) & 15] + w[(t - 13) & 15]) + (w[(t - 14) & 15] + w[(t - 15) & 15])));
                        const float ssum = grp == 0 ? s2 : (grp == 1 ? s4 : (grp == 2 ? s8 : s16)); const int win = 2 << grp;
                        const int n = (t0 + t + 1) < win ? (t0 + t + 1) : win;
                        dp[(size_t)t * POOLW] = (bf16)f2bf(ssum / (float)n - w[t & 15]);
                    }
                }
                for (size_t idx = gt; idx < (size_t)DECB * POOLW; idx += gs) {
                    const int b = (int)(idx >> 10), c = (int)(idx & 1023), win = 2 << (c >> 8), row = MP + b;
                    const float cur = bf2f(PROJ[(size_t)row * PROJ_LD + 4096 + c]); const float* sp = ka->state_pool + (size_t)(l * DECB + b) * 15 * 1024; float sacc = cur;
                    for (int j = 1; j < win; ++j) sacc += sp[(15 - j) * 1024 + c];
                    DB[(size_t)row * POOLW + c] = (bf16)f2bf(sacc / (float)win - cur);
                }
                for (size_t idx = gt; idx < (size_t)NB * 3 * 3072; idx += gs) { const int b = (int)(idx / 9216), r = (int)(idx % 9216), i = r / 3072, c = r % 3072;
                    ka->out[O_CP + (size_t)(l * NB + b) * 9216 + r] = bf2f(PROJ[(size_t)(b * SEQ + SEQ - 3 + i) * PROJ_LD + c]); }
                for (size_t idx = gt; idx < (size_t)NB * 15 * 1024; idx += gs) { const int b = (int)(idx / 15360), r = (int)(idx % 15360), i = r / 1024, c = r % 1024;
                    ka->out[O_PP + (size_t)(l * NB + b) * 15360 + r] = bf2f(PROJ[(size_t)(b * SEQ + SEQ - 15 + i) * PROJ_LD + 4096 + c]); }
                for (size_t idx = gt; idx < (size_t)DECB * 3 * 3072; idx += gs) { const int b = (int)(idx / 9216), r = (int)(idx % 9216), i = r / 3072, c = r % 3072;
                    ka->out[O_CS + (size_t)(l * DECB + b) * 9216 + r] = i < 2 ? ka->state_conv[(size_t)(l * DECB + b) * 9216 + (i + 1) * 3072 + c] : bf2f(PROJ[(size_t)(MP + b) * PROJ_LD + c]); }
                for (size_t idx = gt; idx < (size_t)DECB * 15 * 1024; idx += gs) { const int b = (int)(idx / 15360), r = (int)(idx % 15360), i = r / 1024, c = r % 1024;
                    ka->out[O_PS + (size_t)(l * DECB + b) * 15360 + r] = i < 14 ? ka->state_pool[(size_t)(l * DECB + b) * 15360 + (i + 1) * 1024 + c] : bf2f(PROJ[(size_t)(MP + b) * PROJ_LD + 4096 + c]); }
            }
        }
        SEAM(p0 + 1);
        if (IN(p0 + 2)) {
            PHASE_PTRS();
            ScanP SP{WSP(bf16, WS_DW), WSP(bf16, WS_DQG), WSP(bf16, WS_DQK), WSP(bf16, WS_DKD), WSP(float, WS_DU), WSP(float, WS_EGL), WSP(float, WS_OB), WSP(float, WS_OSSQ), ka->out + O_DP + (size_t)l * NB * NH * 16384};
            unsigned* cnt = (unsigned*)(ka->ws + WS_CTL) + CW_SCAN + l * 32 * 64;
            for (int it = bid; it < NB * NH * 8; it += G) { scan_item(lds, SP, it & 31, it >> 5);
                asm volatile("s_waitcnt vmcnt(0)" ::: "memory"); __syncthreads();
                if (threadIdx.x == 0) __hip_atomic_fetch_add(cnt + (it & 31) * 64, 1u, __ATOMIC_RELAXED, __HIP_MEMORY_SCOPE_AGENT); }
            ph_gemm_pool(lds, DB, WpT + (size_t)l * 4 * 65536, CAT, ka->pool_scale + l * POOLW, G, bid);
            {
                int tl = threadIdx.x; asm volatile("" : "+v"(tl)); const int lane = tl & 63, wave = __builtin_amdgcn_readfirstlane(tl >> 6);
                const float* ob = WSP(float, WS_OB); const float* dn = ka->dn_norm + l * HD;
                const float dn0 = dn[lane], dn1 = dn[64 + lane];
                for (int it = bid; it < NB * NH * 8; it += G) { const int bh = it & 31, sl = it >> 5, b = bh >> 3, h = bh & 7;
                    if (threadIdx.x == 0) { unsigned sp = 0;
                        while (__hip_atomic_load(cnt + bh * 64, __ATOMIC_RELAXED, __HIP_MEMORY_SCOPE_AGENT) < 8u) { __builtin_amdgcn_s_sleep(1); if (++sp > (1u << 22)) break; }
                        __builtin_amdgcn_fence(__ATOMIC_ACQUIRE, "agent"); asm volatile("s_waitcnt vmcnt(0)" ::: "memory"); }
                    __syncthreads();
                    for (int tb = 0; tb < 256; tb += 8 * NWAVES) {
                        float a0[8], a1[8]; bf16 z0[8], z1[8];
#pragma unroll
                        for (int i = 0; i < 8; ++i) { const int row = b * SEQ + sl * 256 + tb + i * NWAVES + wave;
                            a0[i] = ob[(size_t)row * DNW + h * 128 + lane]; a1[i] = ob[(size_t)row * DNW + h * 128 + 64 + lane];
                            z0[i] = PROJ[(size_t)row * PROJ_LD + 3072 + h * 128 + lane]; z1[i] = PROJ[(size_t)row * PROJ_LD + 3072 + h * 128 + 64 + lane]; }
#pragma unroll
                        for (int i = 0; i < 8; ++i) { const int row = b * SEQ + sl * 256 + tb + i * NWAVES + wave;
                            const float ss = wave_sum(a0[i] * a0[i] + a1[i] * a1[i]); const float rs = rsqrt_f(ss * (1.0f / 128.f) + EPS);
                            CAT[(size_t)row * DM + h * 128 + lane] = (bf16)f2bf(a0[i] * rs * dn0 * silu_f(bf2f(z0[i])));
                            CAT[(size_t)row * DM + h * 128 + 64 + lane] = (bf16)f2bf(a1[i] * rs * dn1 * silu_f(bf2f(z1[i]))); }
                    }
                }
            }
        }
        SEAM(p0 + 2);
        if (IN(p0 + 3)) {
            PHASE_PTRS();
            ph_gemm_res(lds, CAT, WoutT + (size_t)l * DM * DM, DM, HB, SSQ, G, bid);
            { int si, ns; short_blocks((MP / 256) * (DM / 256), G, bid, si, ns); dec_res_tiles(lds, CAT, DM, WoutT + (size_t)l * DM * DM, HB, WSP(float, WS_DSSQ), si, ns); }
        }
        SEAM(p0 + 3);
        if (IN(p0 + 4)) {
            PHASE_PTRS();
            ph_gemm_gu(lds, HB, WguT + (size_t)l * 2 * DFF * DM, ACT, SSQ, G, bid);
            { int si, ns; short_blocks((MP / 256) * (2 * DFF / 256), G, bid, si, ns); dec_gu_tiles(lds, HB, WguT + (size_t)l * 2 * DFF * DM, ACT, WSP(float, WS_DSSQ), si, ns);
              if (l + 1 < DEPTH && G == 256) { const CvP CV{ka->w_in, ka->norm_mix, ka->w_out, ka->w_gate_up, ka->norm_ffn, ka->w_down, ka->w_pool, WinT, WoutT, WguT, WdT, WpT}; convert_tail(CV, lds, l + 1, CV_A, si, ns, CV_B); } }
        }
        SEAM(p0 + 4);
        if (IN(p0 + 5)) {
            PHASE_PTRS();
            ph_gemm_res(lds, ACT, WdT + (size_t)l * DM * DFF, DFF, HB, SSQ, G, bid);
            { int si, ns; short_blocks((MP / 256) * (DM / 256), G, bid, si, ns); dec_res_tiles(lds, ACT, DFF, WdT + (size_t)l * DM * DFF, HB, WSP(float, WS_DSSQ), si, ns); }
        }
        SEAM(p0 + 5);
    }
__global__ void __launch_bounds__(NTHR, 2) fwd(Args a) {
    extern __shared__ __attribute__((aligned(16))) unsigned char lds_raw[];
    LAS unsigned char* lds = (LAS unsigned char*)lds_raw;
    volatile LAS unsigned* MISC = (volatile LAS unsigned*)(lds + MISC_OFF);
    const int tid = threadIdx.x, lane = tid & 63, wave = __builtin_amdgcn_readfirstlane(tid >> 6);
    const int G = gridDim.x, bid = blockIdx.x;
    unsigned* ctl = (unsigned*)(KA->ws + WS_CTL);
    if (tid < 32) MISC[tid] = 0u;
    __syncthreads();
    const int lo = KA->ph_lo, hi = KA->ph_hi;
    if (hi - lo > 1) (void)xcd_barrier_post(ctl + CW_BAR, MISC + 8);

    const int gw = bid * NWAVES + wave, NGW = G * NWAVES;

    if (IN(0)) {
        PHASE_PTRS();
        int tl = threadIdx.x; asm volatile("" : "+v"(tl)); const int lane = tl & 63, wave = __builtin_amdgcn_readfirstlane(tl >> 6), gw = bid * NWAVES + wave;
        LAS float* scr = (LAS float*)(lds + wave * 16384);
        const CvP CV{ka->w_in, ka->norm_mix, ka->w_out, ka->w_gate_up, ka->norm_ffn, ka->w_down, ka->w_pool, WinT, WoutT, WguT, WdT, WpT};
        const int skip = (G == 256) ? CV_A + CV_B : 0;
        for (int it = gw; it < DEPTH * I_L; it += NGW) {
            const int l = it / I_L, r = it - l * I_L;
            if (l > 0 && r < skip) continue;
            convert_item(CV, l, r, scr, lane);
        }
        for (int m = gw; m < MPAD; m += NGW) {
            const float* src = m < MP ? ka->x_prompt + (size_t)m * DM : (m < MR ? ka->x_sample + (size_t)(m - MP) * DM : nullptr);
            float s = 0.f;
#pragma unroll
            for (int j = 0; j < 8; ++j) { f32x4 v = src ? *((const f32x4*)src + lane + 64 * j) : (f32x4){0.f, 0.f, 0.f, 0.f};
                s += (v[0] * v[0] + v[1] * v[1]) + (v[2] * v[2] + v[3] * v[3]);
                v2u w; w.x = pk2(v[0], v[1]); w.y = pk2(v[2], v[3]); *((v2u*)(HB + (size_t)m * DM) + lane + 64 * j) = w; }
            s = wave_sum(s);
            if (lane < 32) SSQ[(size_t)m * 32 + lane] = lane == 0 ? s : 0.f;
            if (m >= MP && m < MR) WSP(float, WS_DSSQ)[(size_t)(m - MP) * 64 + lane] = lane == 0 ? s : 0.f;
        }
    }
    SEAM(0);

    layer_phases<0>(lds, lo, hi, G, bid);
    layer_phases<1>(lds, lo, hi, G, bid);
    layer_phases<2>(lds, lo, hi, G, bid);
    layer_phases<3>(lds, lo, hi, G, bid);
    if (IN(N_PHASES - 1)) {
        PHASE_PTRS();
        int tl = threadIdx.x; asm volatile("" : "+v"(tl)); const int lane = tl & 63, gw = bid * NWAVES + __builtin_amdgcn_readfirstlane(tl >> 6);
        for (int m = gw; m < MR; m += NGW) {
            float r;
            if (m < MP) { const f32x4* p = (const f32x4*)(SSQ + (size_t)m * 32); float s = 0.f;
#pragma unroll
                for (int j = 0; j < 8; ++j) { const f32x4 v = p[j]; s += (v[0] + v[1]) + (v[2] + v[3]); }
                r = rsqrt_f(s * (1.0f / DM) + EPS); }
            else r = dec_row_scale(WSP(float, WS_DSSQ), m - MP);
#pragma unroll
            for (int j = 0; j < 8; ++j) { const v2u hv = *((const v2u*)(HB + (size_t)m * DM) + lane + 64 * j); const f32x4 w = *((const f32x4*)ka->norm_final + lane + 64 * j);
                const f32x4 v = (f32x4){__builtin_bit_cast(float, hv.x << 16), __builtin_bit_cast(float, hv.x & 0xffff0000u), __builtin_bit_cast(float, hv.y << 16), __builtin_bit_cast(float, hv.y & 0xffff0000u)};
                *((f32x4*)(ka->out + O_YP + (size_t)m * DM) + lane + 64 * j) = v * r * w; }
        }
    }
}

extern "C" void kernel_launch(void* const* d_in, const int* in_sizes, int n_in, void* d_out, int out_size, void* d_ws, size_t ws_size, hipStream_t stream) {
    static int grid = 0;
    if (grid == 0) {
        if (n_in != 18 || (size_t)out_size != O_END || ws_size < WS_END) { fprintf(stderr, "kernel_launch: unexpected shapes (n_in %d out %d ws %zu need %zu)\n", n_in, out_size, ws_size, (size_t)WS_END); grid = -1; return; }
        int dev = 0, cus = 0, per_cu = 0;
        if (hipGetDevice(&dev) != hipSuccess || hipDeviceGetAttribute(&cus, hipDeviceAttributeMultiprocessorCount, dev) != hipSuccess) { grid = -1; return; }
        if (hipFuncSetAttribute((const void*)fwd, hipFuncAttributeMaxDynamicSharedMemorySize, LDS_BYTES) != hipSuccess) { fprintf(stderr, "kernel_launch: hipFuncSetAttribute failed\n"); grid = -1; return; }
        if (hipOccupancyMaxActiveBlocksPerMultiprocessor(&per_cu, (const void*)fwd, NTHR, LDS_BYTES) != hipSuccess || per_cu < 1) { fprintf(stderr, "kernel_launch: occupancy query says %d\n", per_cu); }
        (void)hipGetLastError();
        grid = cus;
    }
    if (grid < 0) return;
    (void)hipMemsetAsync((char*)d_ws + WS_CTL, 0, CTL_ZERO_BYTES, stream);
    Args a{};
    a.x_prompt = (const float*)d_in[0]; a.x_sample = (const float*)d_in[1]; a.state_delta = (const float*)d_in[2]; a.state_conv = (const float*)d_in[3]; a.state_pool = (const float*)d_in[4];
    a.norm_mix = (const float*)d_in[5]; a.w_in = (const float*)d_in[6]; a.conv_w = (const float*)d_in[7]; a.a_log = (const float*)d_in[8]; a.dt_bias = (const float*)d_in[9];
    a.dn_norm = (const float*)d_in[10]; a.w_pool = (const float*)d_in[11]; a.pool_scale = (const float*)d_in[12]; a.w_out = (const float*)d_in[13]; a.norm_ffn = (const float*)d_in[14];
    a.w_gate_up = (const float*)d_in[15]; a.w_down = (const float*)d_in[16]; a.norm_final = (const float*)d_in[17];
    a.out = (float*)d_out; a.ws = (unsigned char*)d_ws;
#if MK_N_LAUNCHES == 1
    a.ph_lo = 0; a.ph_hi = N_PHASES;
    hipLaunchKernelGGL(fwd, dim3(grid), dim3(NTHR), LDS_BYTES, stream, a);
#else
    for (int p = 0; p < N_PHASES; ++p) { a.ph_lo = p; a.ph_hi = p + 1; hipLaunchKernelGGL(fwd, dim3(grid), dim3(NTHR), LDS_BYTES, stream, a); }
#endif
}
```

```cpp
#include <hip/hip_runtime.h>
#include <cstdio>
#include <cstdint>

#ifndef MK_N_LAUNCHES
#define MK_N_LAUNCHES 1
#endif

namespace pg8 {
#define PG8_LAS __attribute__((address_space(3)))
typedef unsigned short bf16_t;
typedef short bf16x8 __attribute__((ext_vector_type(8)));
typedef float f32x4 __attribute__((ext_vector_type(4)));
typedef unsigned u32x4 __attribute__((ext_vector_type(4)));
typedef unsigned u32x2 __attribute__((ext_vector_type(2)));
constexpr int BM = 256, BK = 64, HALF = 128, HTB = HALF * BK * 2, STAGE_BYTES = 8 * HTB, NXCD = 8, WGM = 8;

__host__ __device__ __forceinline__ int lds_byte(int r, int c) { const int st = (r >> 4) * 2 + (c >> 5), rr = r & 15, cc = c & 31, ob = rr * 64 + cc * 2; return st * 1024 + (ob ^ (((ob >> 9) & 1) << 5)); }
__host__ __device__ __forceinline__ void stage_rc(int b, int& R, int& C) { const int st = b / 1024, sb = b % 1024, swz = sb ^ (((sb >> 9) & 1) << 5); R = (st >> 1) * 16 + swz / 64; C = (st & 1) * 32 + (swz % 64) / 2; }
__host__ __device__ __forceinline__ int perm32(int rho) { const int n = rho >> 4, i = rho & 15; return 8 * (i >> 2) + 4 * n + (i & 3); }

struct Unit { int pm, pn; };
struct Gemm { const bf16_t* A; const bf16_t* Bt; int M, N, K, lda, ldb; long a_pn_bytes; };

struct StaticOrder {
    int nM, nN, nwg, G, c;
    __host__ __device__ void init(int M, int N, int G_, int c_) { nM = M / BM; nN = N / BM; nwg = nM * nN; G = G_; c = c_; }
    __host__ __device__ bool next(int i, Unit& u) const {
        const long L = (long)i * G + c; if (L >= nwg) return false;
        int wgid = (int)L; { const int q = nwg / NXCD, r = nwg % NXCD, xcd = wgid % NXCD, off = wgid / NXCD; wgid = (xcd < r ? xcd * (q + 1) : r * (q + 1) + (xcd - r) * q) + off; }
        const int nig = WGM * nN, gid = wgid / nig, fm = gid * WGM, gsz = (nM - fm) < WGM ? (nM - fm) : WGM;
        u.pm = fm + ((wgid % nig) % gsz); u.pn = (wgid % nig) / gsz; return true;
    }
    __device__ __forceinline__ void a_ready(const Unit&) const {}
    __device__ __forceinline__ void done(const Unit&) const {}
};

__device__ __forceinline__ unsigned cvt_pk_bf16(float lo, float hi) { unsigned r; asm volatile("v_cvt_pk_bf16_f32 %0, %1, %2" : "=v"(r) : "v"(lo), "v"(hi)); return r; }

template <class Epi, class Sched, bool ALIGN_EPI = false, bool SP2 = false>
__device__ __forceinline__ void gemm_phase(PG8_LAS unsigned char* lds, const Gemm g, const Sched& S, const Epi& E) {
    int tid_ = threadIdx.x; asm volatile("" : "+v"(tid_));
    const int tid = tid_, wid = __builtin_amdgcn_readfirstlane(tid >> 6), lane = tid & 63, wr = wid >> 2, wc = wid & 3, fr = lane & 15, fq = lane >> 4;
    const int K = g.K, nt = K / BK;
    unsigned voffA[2], voffB[2];
#pragma unroll
    for (int i = 0; i < 2; ++i) { int R, C; stage_rc(tid * 16 + i * 8192, R, C); const int Rb = Epi::PERM ? ((R & ~31) + perm32(R & 31)) : R;
        voffA[i] = (unsigned)(R * g.lda + C) * 2u; voffB[i] = (unsigned)(Rb * g.ldb + C) * 2u; }
    const size_t kstep = (size_t)(BK * 2);
    const size_t hstepA = (size_t)HALF * g.lda * 2, hstepB = (size_t)HALF * g.ldb * 2;
    const size_t tstepA = 2 * hstepA, tstepB = 2 * hstepB;
    const unsigned ldsw = (unsigned)wid * 1024u;
    const int aoff = lds_byte(wr * 64 + fr, fq * 8), boff = lds_byte(wc * 32 + fr, fq * 8);
#define PG8_SA(b, h) (((b) * 2 + (h)) * HTB)
#define PG8_SB(b, h) ((4 + (b) * 2 + (h)) * HTB)
#define PG8_STAGE(bufoff, gbase, voff) do { _Pragma("unroll") for (int _i = 0; _i < 2; ++_i) { unsigned _vo = (voff)[_i]; asm volatile("" : "+v"(_vo));   \
        __builtin_amdgcn_global_load_lds((const unsigned*)((const char*)(gbase) + _vo), (PG8_LAS unsigned*)(lds + (bufoff) + ldsw + _i * 8192), 16, 0, 0); } } while (0)
#define PG8_LDA(dst, b, h) do { _Pragma("unroll") for (int m = 0; m < 4; ++m) _Pragma("unroll") for (int k = 0; k < 2; ++k) dst[m][k] = *(const PG8_LAS bf16x8*)(lds + PG8_SA(b, h) + aoff + m * 2048 + k * 1024); } while (0)
#define PG8_LDB(dst, b, h) do { _Pragma("unroll") for (int n = 0; n < 2; ++n) _Pragma("unroll") for (int k = 0; k < 2; ++k) dst[n][k] = *(const PG8_LAS bf16x8*)(lds + PG8_SB(b, h) + boff + n * 2048 + k * 1024); } while (0)
#define PG8_MMA(ai, bj, At, Bt) do { __builtin_amdgcn_s_setprio(1); _Pragma("unroll") for (int m = 0; m < 4; ++m) _Pragma("unroll") for (int n = 0; n < 2; ++n) _Pragma("unroll") for (int k = 0; k < 2; ++k) \
        acc[ai][bj][m][n] = __builtin_amdgcn_mfma_f32_16x16x32_bf16(Bt[n][k], At[m][k], acc[ai][bj][m][n], 0, 0, 0); __builtin_amdgcn_s_setprio(0); } while (0)
#define PG8_WAIT_V(n) asm volatile("s_waitcnt vmcnt(" #n ")" ::: "memory")
#define PG8_WAIT_L(n) asm volatile("s_waitcnt lgkmcnt(" #n ")" ::: "memory")
#define PG8_BAR __builtin_amdgcn_s_barrier()
#define PG8_SCHED __builtin_amdgcn_sched_barrier(0)
    Unit cur, nxt; int ui = 0;
    if (!S.next(0, cur)) return;
    f32x4 acc[2][2][4][2];
#pragma unroll
    for (int a = 0; a < 2; ++a)
#pragma unroll
        for (int b = 0; b < 2; ++b)
#pragma unroll
            for (int m = 0; m < 4; ++m)
#pragma unroll
                for (int n = 0; n < 2; ++n) acc[a][b][m][n] = (f32x4){0.f, 0.f, 0.f, 0.f};
    bf16x8 At[4][2], B0[2][2], B1[2][2];
    const char* cA = (const char*)g.A + (size_t)cur.pm * tstepA + (size_t)cur.pn * g.a_pn_bytes; const char* cB = (const char*)g.Bt + (size_t)cur.pn * tstepB;
    S.a_ready(cur);
    if constexpr (SP2) {
        PG8_STAGE(PG8_SB(0, 0), cB, voffB); PG8_STAGE(PG8_SB(0, 1), cB + hstepB, voffB); PG8_STAGE(PG8_SA(0, 0), cA, voffA); PG8_STAGE(PG8_SA(0, 1), cA + hstepA, voffA);
        if (wr == 1) PG8_BAR;
        PG8_WAIT_V(2); PG8_BAR;
        PG8_STAGE(PG8_SB(1, 0), cB + kstep, voffB); PG8_STAGE(PG8_SA(1, 0), cA + kstep, voffA); PG8_STAGE(PG8_SB(1, 1), cB + hstepB + kstep, voffB);
        PG8_WAIT_V(6); PG8_BAR;
    } else {
        PG8_STAGE(PG8_SB(0, 0), cB, voffB); PG8_STAGE(PG8_SA(0, 0), cA, voffA); PG8_STAGE(PG8_SB(0, 1), cB + hstepB, voffB); PG8_STAGE(PG8_SA(0, 1), cA + hstepA, voffA);
        if (wr == 1) PG8_BAR;
        PG8_WAIT_V(4); PG8_BAR;
        PG8_STAGE(PG8_SB(1, 0), cB + kstep, voffB); PG8_STAGE(PG8_SA(1, 0), cA + kstep, voffA); PG8_STAGE(PG8_SB(1, 1), cB + hstepB + kstep, voffB);
        PG8_WAIT_V(6); PG8_BAR;
    }
    for (;;) {
        const bool has_next = S.next(ui + 1, nxt);
        const char* nA = has_next ? (const char*)g.A + (size_t)nxt.pm * tstepA + (size_t)nxt.pn * g.a_pn_bytes : cA; const char* nB = has_next ? (const char*)g.Bt + (size_t)nxt.pn * tstepB : cB;
        for (int t = 0; t < nt; t += 2) {
            const bool last = (t == nt - 2);
            const char* a1 = cA + (size_t)(t + 1) * kstep;
            const char* a2 = last ? nA : cA + (size_t)(t + 2) * kstep; const char* b2 = last ? nB : cB + (size_t)(t + 2) * kstep;
            const char* a3 = a2 + kstep; const char* b3 = b2 + kstep;
            if (last && has_next) S.a_ready(nxt);
            if constexpr (SP2) {
            PG8_LDB(B0, 0, 0); PG8_LDB(B1, 0, 1); PG8_SCHED; PG8_LDA(At, 0, 0); PG8_STAGE(PG8_SA(1, 1), a1 + hstepA, voffA);
            PG8_WAIT_V(8); PG8_WAIT_L(0); PG8_BAR; PG8_MMA(0, 0, At, B0); PG8_MMA(0, 1, At, B1); PG8_BAR; PG8_SCHED;
            PG8_LDA(At, 0, 1); PG8_STAGE(PG8_SB(0, 0), b2, voffB); PG8_STAGE(PG8_SB(0, 1), b2 + hstepB, voffB); PG8_STAGE(PG8_SA(0, 0), a2, voffA);
            PG8_WAIT_V(8); PG8_WAIT_L(0); PG8_BAR; PG8_MMA(1, 0, At, B0); PG8_MMA(1, 1, At, B1); PG8_BAR; PG8_SCHED;
            PG8_LDB(B0, 1, 0); PG8_LDB(B1, 1, 1); PG8_SCHED; PG8_LDA(At, 1, 0); PG8_STAGE(PG8_SA(0, 1), a2 + hstepA, voffA);
            PG8_WAIT_V(8); PG8_WAIT_L(0); PG8_BAR; PG8_MMA(0, 0, At, B0); PG8_MMA(0, 1, At, B1); PG8_BAR; PG8_SCHED;
            PG8_LDA(At, 1, 1); PG8_STAGE(PG8_SB(1, 0), b3, voffB); PG8_STAGE(PG8_SB(1, 1), b3 + hstepB, voffB); PG8_STAGE(PG8_SA(1, 0), a3, voffA);
            PG8_WAIT_V(8); PG8_WAIT_L(0); PG8_BAR; PG8_MMA(1, 0, At, B0); PG8_MMA(1, 1, At, B1); PG8_BAR; PG8_SCHED;
            } else {
            PG8_LDB(B0, 0, 0); PG8_SCHED; PG8_LDA(At, 0, 0); PG8_STAGE(PG8_SA(1, 1), a1 + hstepA, voffA);
            PG8_WAIT_L(8); PG8_BAR; PG8_WAIT_L(0); PG8_MMA(0, 0, At, B0); PG8_BAR; PG8_SCHED;
            PG8_LDB(B1, 0, 1); PG8_STAGE(PG8_SB(0, 0), b2, voffB);
            PG8_BAR; PG8_WAIT_L(0); PG8_MMA(0, 1, At, B1); PG8_BAR;
            PG8_LDA(At, 0, 1); PG8_STAGE(PG8_SA(0, 0), a2, voffA);
            PG8_BAR; PG8_WAIT_L(0); PG8_MMA(1, 0, At, B0); PG8_BAR; PG8_SCHED;
            PG8_STAGE(PG8_SB(0, 1), b2 + hstepB, voffB);
            PG8_WAIT_V(6); PG8_BAR; PG8_MMA(1, 1, At, B1); PG8_BAR;
            PG8_LDB(B0, 1, 0); PG8_SCHED; PG8_LDA(At, 1, 0); PG8_STAGE(PG8_SA(0, 1), a2 + hstepA, voffA);
            PG8_WAIT_L(8); PG8_BAR; PG8_WAIT_L(0); PG8_MMA(0, 0, At, B0); PG8_BAR; PG8_SCHED;
            PG8_LDB(B1, 1, 1); PG8_STAGE(PG8_SB(1, 0), b3, voffB);
            PG8_BAR; PG8_WAIT_L(0); PG8_MMA(0, 1, At, B1); PG8_BAR;
            PG8_LDA(At, 1, 1); PG8_STAGE(PG8_SA(1, 0), a3, voffA);
            PG8_BAR; PG8_WAIT_L(0); PG8_MMA(1, 0, At, B0); PG8_BAR; PG8_SCHED;
            PG8_STAGE(PG8_SB(1, 1), b3 + hstepB, voffB);
            PG8_WAIT_V(6); PG8_BAR; PG8_MMA(1, 1, At, B1); PG8_BAR;
            }
        }
        if constexpr (ALIGN_EPI) { if (wr == 0) PG8_BAR; }
        E(acc, cur, wr, wc, fr, fq); S.done(cur);
        if (!has_next) break;
#pragma unroll
        for (int a = 0; a < 2; ++a)
#pragma unroll
            for (int b = 0; b < 2; ++b)
#pragma unroll
                for (int m = 0; m < 4; ++m)
#pragma unroll
                    for (int n = 0; n < 2; ++n) acc[a][b][m][n] = (f32x4){0.f, 0.f, 0.f, 0.f};
        cur = nxt; cA = nA; cB = nB; ++ui;
        if constexpr (ALIGN_EPI) { if (wr == 1) PG8_BAR; }
    }
    PG8_WAIT_V(0);
    if constexpr (!ALIGN_EPI) { if (wr == 0) PG8_BAR; }
    PG8_BAR;
#undef PG8_SA
#undef PG8_SB
#undef PG8_STAGE
#undef PG8_LDA
#undef PG8_LDB
#undef PG8_MMA
#undef PG8_WAIT_V
#undef PG8_WAIT_L
#undef PG8_BAR
#undef PG8_SCHED
}
}

constexpr int NWAVES = 8, NTHR = 512;
constexpr int DM = 2048, NB = 4, SEQ = 2048, DEPTH = 4, DECB = 128;
constexpr int DNW = 1024, NH = 8, HD = 128, POOLW = 1024, DFF = 5632, INC = 5136;
constexpr int MP = NB * SEQ;
constexpr int MR = MP + DECB;
constexpr int MPAD = 8448;
constexpr int NIN = 5376;
constexpr int PROJ_LD = 5120;
constexpr float EPS = 1e-6f;

constexpr size_t O_YP = 0, O_YS = 16777216, O_DP = 17039360, O_CP = 19136512, O_PP = 19283968, O_DS = 19529728, O_CS = 86638592, O_PS = 91357184, O_END = 99221504;

constexpr size_t MiB = 1u << 20;
constexpr size_t WS_CTL = 0, CTL_ZERO_BYTES = 1 * MiB;
constexpr size_t SZ_WIN = (size_t)NIN * DM * 2, SZ_WOUT = (size_t)DM * DM * 2, SZ_WGU = (size_t)2 * DFF * DM * 2, SZ_WD = (size_t)DM * DFF * 2, SZ_WP = (size_t)4 * 256 * 256 * 2;
constexpr size_t WS_WIN = 2 * MiB;
constexpr size_t WS_WOUT = WS_WIN + DEPTH * SZ_WIN;
constexpr size_t WS_WGU = WS_WOUT + DEPTH * SZ_WOUT;
constexpr size_t WS_WD = WS_WGU + DEPTH * SZ_WGU;
constexpr size_t WS_WP = WS_WD + DEPTH * SZ_WD;
constexpr size_t WS_H = WS_WP + DEPTH * SZ_WP;
constexpr size_t WS_HB = WS_H + (size_t)MPAD * DM * 4;
constexpr size_t WS_PROJ = WS_HB + (size_t)MPAD * DM * 2;
constexpr size_t WS_BA = WS_PROJ + (size_t)MPAD * PROJ_LD * 2;
constexpr size_t WS_CAT = WS_BA + (size_t)MPAD * 16 * 4;
constexpr size_t WS_DB = WS_CAT + (size_t)MPAD * DM * 2;
constexpr size_t WS_ACT = WS_DB + (size_t)MPAD * POOLW * 2;
constexpr size_t WS_SSQ = WS_ACT + (size_t)MPAD * DFF * 2;
constexpr int NUNIT = NB * NH * (SEQ / 64);
constexpr size_t WS_DW = WS_SSQ + (size_t)MPAD * 32 * 4;
constexpr size_t WS_DQG = WS_DW + (size_t)NUNIT * 64 * 128 * 2;
constexpr size_t WS_DQK = WS_DQG + (size_t)NUNIT * 64 * 128 * 2;
constexpr size_t WS_DKD = WS_DQK + (size_t)NUNIT * 64 * 64 * 2;
constexpr size_t WS_DU = WS_DKD + (size_t)NUNIT * 128 * 64 * 2;
constexpr size_t WS_EGL = WS_DU + (size_t)NUNIT * 128 * 64 * 4;
constexpr size_t WS_OB = WS_EGL + (size_t)NUNIT * 4;
constexpr size_t WS_OSSQ = WS_OB + (size_t)MP * DNW * 4;
constexpr size_t WS_DSSQ = WS_OSSQ + (size_t)MP * 64 * 4;
constexpr size_t WS_END = WS_DSSQ + (size_t)DECB * 64 * 4;
constexpr int CW_BAR = 4096, CW_SCAN = 8192;

constexpr int LDS_BYTES = 147456;
constexpr int MISC_OFF = 131072 + 8192 + 4096;

#define LAS __attribute__((address_space(3)))
typedef unsigned short bf16;
typedef unsigned v4u __attribute__((ext_vector_type(4)));
typedef unsigned v2u __attribute__((ext_vector_type(2)));
typedef float f32x4 __attribute__((ext_vector_type(4)));
#define LDS_WAIT() asm volatile("s_waitcnt lgkmcnt(0)" ::: "memory")
#define VM_WAIT() asm volatile("s_waitcnt vmcnt(0)" ::: "memory")
__device__ __forceinline__ unsigned f2bf(float f) { unsigned u = __builtin_bit_cast(unsigned, f); return (u + 0x7fffu + ((u >> 16) & 1u)) >> 16; }
__device__ __forceinline__ unsigned pk2(float lo, float hi) { return f2bf(lo) | (f2bf(hi) << 16); }
__device__ __forceinline__ float bf2f(bf16 b) { return __builtin_bit_cast(float, ((unsigned)b) << 16); }
__device__ __forceinline__ float silu_f(float x) { return x * __builtin_amdgcn_rcpf(1.0f + __expf(-x)); }
__device__ __forceinline__ float sigmoid_f(float x) { return __builtin_amdgcn_rcpf(1.0f + __expf(-x)); }
__device__ __forceinline__ float softplus_f(float x) { const float e = __expf(x); const float sm = e * (1.0f - e * (0.5f - e * 0.33333333f)); const float lg = __logf(1.0f + e); return x > 20.f ? x : (e < 0.01f ? sm : lg); }
__device__ __forceinline__ float rsqrt_f(float x) { return __builtin_amdgcn_rsqf(x); }
__device__ __forceinline__ float dpp_f(float v, const int ctrl_sel) { return v; }
#define DPP_ADD(v, ctrl, rmask) do { const int t_ = __builtin_amdgcn_update_dpp(0, __builtin_bit_cast(int, (v)), (ctrl), (rmask), 0xF, false); (v) += __builtin_bit_cast(float, t_); } while (0)
__device__ __forceinline__ float row_sum16(float v) {
    DPP_ADD(v, 0xB1, 0xF);
    DPP_ADD(v, 0x4E, 0xF);
    DPP_ADD(v, 0x141, 0xF);
    DPP_ADD(v, 0x140, 0xF);
    return v;
}
__device__ __forceinline__ float wave_sum(float v) {
    v = row_sum16(v);
    DPP_ADD(v, 0x142, 0xA);
    DPP_ADD(v, 0x143, 0xC);
    return __builtin_bit_cast(float, __builtin_amdgcn_readlane(__builtin_bit_cast(int, v), 63));
}

#define XB_TMO      128
#define XB_XCNT(j)  (256  + 64 * (j))
#define XB_XSUB(j)  (1280 + 64 * (j))
#define XB_XGEN(j)  (2304 + 64 * (j))
#define XB_TOP      3328
#define XB_TOPGEN   3392
#define XCD_BAR_WORDS 3456
#define XB_SPIN_CAP (1u << 22)
__device__ __forceinline__ unsigned xb_ld(unsigned* p)              { return __hip_atomic_load(p, __ATOMIC_RELAXED, __HIP_MEMORY_SCOPE_AGENT); }
__device__ __forceinline__ unsigned xb_add(unsigned* p, unsigned v) { return __hip_atomic_fetch_add(p, v, __ATOMIC_RELAXED, __HIP_MEMORY_SCOPE_AGENT); }
__device__ __forceinline__ unsigned xb_xcc_id() { return (unsigned)__builtin_amdgcn_s_getreg((3 << 11) | 20) & 0xFu; }
#define XB_SPIN(cond, bar) do { unsigned _sp = 0; while (cond) { __builtin_amdgcn_s_sleep(1); \
    if ((++_sp & 255u) == 0u) { if (xb_ld(&(bar)[XB_TMO])) break; if (_sp > XB_SPIN_CAP) { atomicAdd(&(bar)[XB_TMO], 1u); break; } } } } while (0)
struct XcdBarrier { unsigned* bar; unsigned x; volatile LAS unsigned* st; };
__device__ __forceinline__ XcdBarrier xcd_barrier_post(unsigned* bar, volatile LAS unsigned* st) {
    XcdBarrier b; b.bar = bar; b.x = xb_xcc_id(); b.st = st;
    if (threadIdx.x == 0) (void)xb_add(&bar[XB_XCNT(b.x)], 1u);
    return b;
}
__device__ __forceinline__ void xcd_barrier_complete(unsigned* bar, unsigned x, unsigned& nloc, unsigned& nx) {
    const unsigned G = gridDim.x * gridDim.y * gridDim.z;
    unsigned sum, cnt, mine, sp = 0u;
    for (;;) {
        sum = 0u; cnt = 0u; mine = 0u;
#pragma unroll
        for (unsigned j = 0; j < 16; ++j) { const unsigned c = xb_ld(&bar[XB_XCNT(j)]); sum += c; cnt += (c > 0u) ? 1u : 0u; mine = (j == x) ? c : mine; }
        if (sum == G) break;
        __builtin_amdgcn_s_sleep(1);
        if ((++sp & 255u) == 0u) { if (xb_ld(&bar[XB_TMO])) break; if (sp > XB_SPIN_CAP) { atomicAdd(&bar[XB_TMO], 1u); break; } }
    }
    nloc = mine > 0u ? mine : 1u; nx = cnt > 0u ? cnt : 1u;
}
__device__ __forceinline__ void xcd_barrier(const XcdBarrier& b) {
    asm volatile("s_waitcnt vmcnt(0)" ::: "memory");
    __syncthreads();
    if (threadIdx.x == 0) {
        unsigned* bar = b.bar;
        __builtin_amdgcn_s_waitcnt(0);
        unsigned nloc = b.st[0], nx = b.st[1];
        if (nloc == 0u) { xcd_barrier_complete(bar, b.x, nloc, nx); b.st[0] = nloc; b.st[1] = nx; }
        const unsigned old = xb_add(&bar[XB_XSUB(b.x)], 1u);
        const unsigned gen = old / nloc;
        if (old + 1u == (gen + 1u) * nloc) {
            __builtin_amdgcn_fence(__ATOMIC_RELEASE, "agent");
            asm volatile("s_waitcnt vmcnt(0)" ::: "memory");
            const unsigned og = xb_add(&bar[XB_TOP], 1u);
            const unsigned tg = og / nx;
            if (og + 1u == (tg + 1u) * nx) xb_add(&bar[XB_TOPGEN], 1u);
            else XB_SPIN(xb_ld(&bar[XB_TOPGEN]) == tg, bar);
            __builtin_amdgcn_fence(__ATOMIC_ACQUIRE, "agent");
            xb_add(&bar[XB_XGEN(b.x)], 1u);
            asm volatile("s_waitcnt vmcnt(0)" ::: "memory");
        } else {
            XB_SPIN(xb_ld(&bar[XB_XGEN(b.x)]) == gen, bar);
            __builtin_amdgcn_fence(__ATOMIC_ACQUIRE, "agent");
            asm volatile("s_waitcnt vmcnt(0)" ::: "memory");
        }
    }
    __syncthreads();
}

struct Args {
    const float *x_prompt, *x_sample, *state_delta, *state_conv, *state_pool, *norm_mix, *w_in, *conv_w, *a_log, *dt_bias, *dn_norm, *w_pool, *pool_scale, *w_out, *norm_ffn, *w_gate_up, *w_down, *norm_final;
    float* out; unsigned char* ws; int ph_lo, ph_hi;
};

__device__ __forceinline__ void tr_item(const float* W, int ldw, const float* kscale, bf16* WT, int K, int k0, int d0, int sc, LAS float* scr, int lane) {
    float tv[32];
#pragma unroll
    for (int i = 0; i < 32; ++i) { const int kk = 2 * i + (lane >> 5); tv[i] = sc >= 0 ? W[(size_t)(k0 + kk) * ldw + sc] : 0.f; }
#pragma unroll
    for (int i = 0; i < 32; ++i) { const int kk = 2 * i + (lane >> 5); float v = tv[i]; if (kscale) v *= kscale[k0 + kk]; scr[kk * 33 + (lane & 31)] = v; }
    LDS_WAIT(); asm volatile("" ::: "memory");
    const int c = lane & 7;
#pragma unroll
    for (int j = 0; j < 4; ++j) { const int n = (lane >> 3) + 8 * j; const LAS float* s = scr + (8 * c) * 33 + n;
        v4u o; o.x = pk2(s[0 * 33], s[1 * 33]); o.y = pk2(s[2 * 33], s[3 * 33]); o.z = pk2(s[4 * 33], s[5 * 33]); o.w = pk2(s[6 * 33], s[7 * 33]);
        *(v4u*)(WT + (size_t)(d0 + n) * K + k0 + 8 * c) = o; }
    LDS_WAIT(); asm volatile("" ::: "memory");
}
__device__ __forceinline__ int srccol_in(int d) { return d < 4096 ? d : (d < 5120 ? d + 16 : (d < 5136 ? d - 1024 : -1)); }
__device__ __forceinline__ int srccol_gu(int d) { const int j = d >> 8, w = d & 255; return w < 128 ? 128 * j + w : DFF + 128 * j + (w - 128); }
constexpr int I_IN = 32 * (NIN / 32), I_OUT = 32 * 64, I_GU = 32 * (2 * DFF / 32), I_D = (DFF / 64) * 64, I_P = 4 * 4 * 8, I_L = I_IN + I_OUT + I_GU + I_D + I_P;
constexpr int CV_PER_WG = 24;
constexpr int CV_A = 96 * CV_PER_WG, CV_B = 128 * CV_PER_WG;
struct CvP { const float *w_in, *norm_mix, *w_out, *w_gate_up, *norm_ffn, *w_down, *w_pool; bf16 *WinT, *WoutT, *WguT, *WdT, *WpT; };
__device__ __forceinline__ void convert_item(const CvP& C, int l, int r, LAS float* scr, int lane) {
    if (r < I_IN) { const int nblk = NIN / 32, kb = r / nblk, nb = r % nblk; tr_item(C.w_in + (size_t)l * DM * INC, INC, C.norm_mix + l * DM, C.WinT + (size_t)l * NIN * DM, DM, 64 * kb, 32 * nb, srccol_in(32 * nb + (lane & 31)), scr, lane); return; } r -= I_IN;
    if (r < I_OUT) { const int kb = r / 64, nb = r % 64; tr_item(C.w_out + (size_t)l * DM * DM, DM, nullptr, C.WoutT + (size_t)l * DM * DM, DM, 64 * kb, 32 * nb, 32 * nb + (lane & 31), scr, lane); return; } r -= I_OUT;
    if (r < I_GU) { const int nblk = 2 * DFF / 32, kb = r / nblk, nb = r % nblk; tr_item(C.w_gate_up + (size_t)l * DM * 2 * DFF, 2 * DFF, C.norm_ffn + l * DM, C.WguT + (size_t)l * 2 * DFF * DM, DM, 64 * kb, 32 * nb, srccol_gu(32 * nb + (lane & 31)), scr, lane); return; } r -= I_GU;
    if (r < I_D) { const int kb = r / 64, nb = r % 64; tr_item(C.w_down + (size_t)l * DFF * DM, DM, nullptr, C.WdT + (size_t)l * DM * DFF, DFF, 64 * kb, 32 * nb, 32 * nb + (lane & 31), scr, lane); return; } r -= I_D;
    { const int g = r / 32, rr = r % 32, kb = rr / 8, nb = rr % 8; tr_item(C.w_pool + (size_t)(l * 4 + g) * 65536, 256, nullptr, C.WpT + (size_t)(l * 4 + g) * 65536, 256, 64 * kb, 32 * nb, 32 * nb + (lane & 31), scr, lane); }
}
__device__ __forceinline__ void convert_tail(const CvP& C, LAS unsigned char* lds, int l_next, int base, int si, int ns, int quota) {
    if (si < 0) return;
    int tl = threadIdx.x; asm volatile("" : "+v"(tl)); const int lane = tl & 63, wave = __builtin_amdgcn_readfirstlane(tl >> 6);
    LAS float* scr = (LAS float*)(lds + wave * 16384);
    for (int j = wave; j < CV_PER_WG; j += NWAVES) { const int r = j * ns + si; if (r < quota) convert_item(C, l_next, base + r, scr, lane); }
    __syncthreads();
}

__device__ __forceinline__ float row_scale1(const float* ssq, int row, int fq) {
    const f32x4* p = (const f32x4*)(ssq + (size_t)row * 32 + 8 * fq); const f32x4 a = p[0], b = p[1];
    float s = ((a[0] + a[1]) + (a[2] + a[3])) + ((b[0] + b[1]) + (b[2] + b[3])); s += __shfl_xor(s, 16); s += __shfl_xor(s, 32);
    return rsqrt_f(s * (1.0f / DM) + EPS);
}
#define EPI_FENCE() asm volatile("" ::: "memory")
struct EpiIn {
    static constexpr bool PERM = true;
    bf16* proj; float* ba; const float* ssq;
    __device__ __forceinline__ void operator()(const f32x4 (&acc)[2][2][4][2], const pg8::Unit& u, int wr, int wc, int fr_, int fq_) const {
        int fr = fr_, fq = fq_; asm volatile("" : "+v"(fr), "+v"(fq));
        const int row0 = u.pm * 256 + wr * 64 + fr;
        if (u.pn < 20) {
            const int col0 = u.pn * 256 + wc * 32 + 8 * fq;
#pragma unroll
            for (int ai = 0; ai < 2; ++ai)
#pragma unroll
                for (int m = 0; m < 4; ++m) { const int row = row0 + ai * 128 + m * 16; bf16* rowp = proj + (size_t)row * PROJ_LD + col0; const float r = row_scale1(ssq, row, fq);
#pragma unroll
                    for (int bj = 0; bj < 2; ++bj) { const f32x4 v0 = acc[ai][bj][m][0] * r, v1 = acc[ai][bj][m][1] * r;
                        v4u w; w.x = pg8::cvt_pk_bf16(v0[0], v0[1]); w.y = pg8::cvt_pk_bf16(v0[2], v0[3]); w.z = pg8::cvt_pk_bf16(v1[0], v1[1]); w.w = pg8::cvt_pk_bf16(v1[2], v1[3]);
                        *(v4u*)(rowp + bj * 128) = w; }
                    EPI_FENCE(); }
        } else {
#pragma unroll
            for (int ai = 0; ai < 2; ++ai)
#pragma unroll
                for (int m = 0; m < 4; ++m) { const int row = row0 + ai * 128 + m * 16; const float r = row_scale1(ssq, row, fq);
                    if (wc == 0 && fq < 2) { float* rowp = ba + (size_t)row * 16 + 8 * fq; *(f32x4*)(rowp) = acc[ai][0][m][0] * r; *(f32x4*)(rowp + 4) = acc[ai][0][m][1] * r; }
                    EPI_FENCE(); }
        }
    }
};
struct EpiRes {
    static constexpr bool PERM = true;
    bf16* hb; float* ssq;
    __device__ __forceinline__ void operator()(const f32x4 (&acc)[2][2][4][2], const pg8::Unit& u, int wr, int wc, int fr_, int fq_) const {
        int fr = fr_, fq = fq_; asm volatile("" : "+v"(fr), "+v"(fq));
        const int row0 = u.pm * 256 + wr * 64 + fr, col0 = u.pn * 256 + wc * 32 + 8 * fq;
#pragma unroll
        for (int ai = 0; ai < 2; ++ai)
#pragma unroll
            for (int m = 0; m < 4; ++m) { const int row = row0 + ai * 128 + m * 16; bf16* bp = hb + (size_t)row * DM + col0; float sq = 0.f;
#pragma unroll
                for (int bj = 0; bj < 2; ++bj) { const v4u o = *(const v4u*)(bp + bj * 128);
                    f32x4 v0 = acc[ai][bj][m][0], v1 = acc[ai][bj][m][1];
                    v0[0] += __builtin_bit_cast(float, o.x << 16); v0[1] += __builtin_bit_cast(float, o.x & 0xffff0000u); v0[2] += __builtin_bit_cast(float, o.y << 16); v0[3] += __builtin_bit_cast(float, o.y & 0xffff0000u);
                    v1[0] += __builtin_bit_cast(float, o.z << 16); v1[1] += __builtin_bit_cast(float, o.z & 0xffff0000u); v1[2] += __builtin_bit_cast(float, o.w << 16); v1[3] += __builtin_bit_cast(float, o.w & 0xffff0000u);
                    sq += ((v0[0] * v0[0] + v0[1] * v0[1]) + (v0[2] * v0[2] + v0[3] * v0[3])) + ((v1[0] * v1[0] + v1[1] * v1[1]) + (v1[2] * v1[2] + v1[3] * v1[3]));
                    v4u w; w.x = pg8::cvt_pk_bf16(v0[0], v0[1]); w.y = pg8::cvt_pk_bf16(v0[2], v0[3]); w.z = pg8::cvt_pk_bf16(v1[0], v1[1]); w.w = pg8::cvt_pk_bf16(v1[2], v1[3]);
                    *(v4u*)(bp + bj * 128) = w; }
                sq += __shfl_xor(sq, 16); sq += __shfl_xor(sq, 32);
                if (fq == 0) ssq[(size_t)row * 32 + u.pn * 4 + wc] = sq;
                EPI_FENCE(); }
    }
};
struct EpiSwiGLU {
    static constexpr bool PERM = true;
    bf16* act; const float* ssq;
    __device__ __forceinline__ void operator()(const f32x4 (&acc)[2][2][4][2], const pg8::Unit& u, int wr, int wc, int fr_, int fq_) const {
        int fr = fr_, fq = fq_; asm volatile("" : "+v"(fr), "+v"(fq));
        const int row0 = u.pm * 256 + wr * 64 + fr, col0 = u.pn * 128 + wc * 32 + 8 * fq;
#pragma unroll
        for (int ai = 0; ai < 2; ++ai)
#pragma unroll
            for (int m = 0; m < 4; ++m) { const int row = row0 + ai * 128 + m * 16; const float r = row_scale1(ssq, row, fq); v4u w;
#pragma unroll
                for (int n = 0; n < 2; ++n) { const f32x4 gt = acc[ai][0][m][n] * r, up = acc[ai][1][m][n] * r;
                    const float o0 = silu_f(gt[0]) * up[0], o1 = silu_f(gt[1]) * up[1], o2 = silu_f(gt[2]) * up[2], o3 = silu_f(gt[3]) * up[3];
                    const unsigned lo = pg8::cvt_pk_bf16(o0, o1), hi = pg8::cvt_pk_bf16(o2, o3);
                    if (n == 0) { w.x = lo; w.y = hi; } else { w.z = lo; w.w = hi; } }
                *(v4u*)(act + (size_t)row * DFF + col0) = w;
                EPI_FENCE(); }
    }
};
struct EpiPool {
    static constexpr bool PERM = true;
    bf16* cat; const float* scale;
    __device__ __forceinline__ void operator()(const f32x4 (&acc)[2][2][4][2], const pg8::Unit& u, int wr, int wc, int fr_, int fq_) const {
        int fr = fr_, fq = fq_; asm volatile("" : "+v"(fr), "+v"(fq));
        const int row0 = u.pm * 256 + wr * 64 + fr, col0 = u.pn * 256 + wc * 32 + 8 * fq;
#pragma unroll
        for (int bj = 0; bj < 2; ++bj) { const f32x4 s0 = *(const f32x4*)(scale + col0 + bj * 128), s1 = *(const f32x4*)(scale + col0 + bj * 128 + 4);
#pragma unroll
            for (int ai = 0; ai < 2; ++ai)
#pragma unroll
                for (int m = 0; m < 4; ++m) { bf16* rowp = cat + (size_t)(row0 + ai * 128 + m * 16) * DM + DNW + col0;
                    const f32x4 v0 = acc[ai][bj][m][0] * s0, v1 = acc[ai][bj][m][1] * s1;
                    v4u w; w.x = pg8::cvt_pk_bf16(v0[0], v0[1]); w.y = pg8::cvt_pk_bf16(v0[2], v0[3]); w.z = pg8::cvt_pk_bf16(v1[0], v1[1]); w.w = pg8::cvt_pk_bf16(v1[2], v1[3]);
                    *(v4u*)(rowp + bj * 128) = w; }
            EPI_FENCE(); }
    }
};

struct MixP {
    const bf16* proj; const float* ba; bf16* cat; const float *conv_w, *a_log, *dt_bias, *dn_norm;
};
__device__ __forceinline__ void delta_seq(LAS unsigned char* lds, const MixP& P, int row_base, int ntok_total, int h, const float* S0, const float* cstate  , float* Sout) {
    LAS float* qs = (LAS float*)lds; LAS float* ks = qs + 64 * 128; LAS float* vs = ks + 64 * 128; LAS float* os = vs + 64 * 128;
    LAS float* bt = os + 64 * 128; LAS float* egs = bt + 64;
    int tid_ = threadIdx.x; asm volatile("" : "+v"(tid_));
    const int tid = tid_, lane = tid & 63, wave = tid >> 6, vcol = tid >> 2, kq = tid & 3;
    float S[32];
#pragma unroll
    for (int i = 0; i < 32; ++i) S[i] = S0 ? S0[(size_t)(32 * kq + i) * 128 + vcol] : 0.f;
    const float Ah = __expf(P.a_log[h]), dtb = P.dt_bias[h];
    for (int t0 = 0; t0 < ntok_total; t0 += 64) {
        const int nt = (ntok_total - t0) < 64 ? (ntok_total - t0) : 64;
        for (int idx = tid; idx < nt * 384; idx += NTHR) {
            const int t = idx / 384, c = idx - t * 384, part = c >> 7, cc = c & 127, col = part * 1024 + h * 128 + cc; float y = 0.f;
#pragma unroll
            for (int i = 0; i < 4; ++i) { const int tt = t0 + t - 3 + i; float pv;
                if (tt >= 0) pv = bf2f(P.proj[(size_t)(row_base + tt) * PROJ_LD + col]); else pv = cstate ? cstate[(3 + tt) * 3072 + col] : 0.f;
                y += pv * P.conv_w[i * 3072 + col]; }
            y = silu_f(y);
            (part == 0 ? qs : (part == 1 ? ks : vs))[t * 128 + cc] = y;
        }
        if (tid < nt) { const int row = row_base + t0 + tid; const float braw = P.ba[(size_t)row * 16 + h], araw = P.ba[(size_t)row * 16 + 8 + h];
            bt[tid] = sigmoid_f(braw); egs[tid] = __expf(-Ah * softplus_f(araw + dtb)); }
        __syncthreads();
        for (int pr = wave; pr < 2 * nt; pr += NWAVES) { const int t = pr >> 1; LAS float* p = (pr & 1) ? ks : qs; const float a = p[t * 128 + lane], b = p[t * 128 + 64 + lane];
            const float ss = wave_sum(a * a + b * b); float sc = rsqrt_f(ss + EPS); if (!(pr & 1)) sc *= 0.08838834764831845f;
            p[t * 128 + lane] = a * sc; p[t * 128 + 64 + lane] = b * sc; }
        __syncthreads();
        for (int t = 0; t < nt; ++t) {
            const float eg = egs[t], beta = bt[t], vv = vs[t * 128 + vcol];
            const LAS f32x4* kp = (const LAS f32x4*)(ks + t * 128 + 32 * kq); const LAS f32x4* qp = (const LAS f32x4*)(qs + t * 128 + 32 * kq);
            float kr[32]; float kv = 0.f;
#pragma unroll
            for (int i = 0; i < 8; ++i) { const f32x4 k4 = kp[i]; kr[4 * i] = k4[0]; kr[4 * i + 1] = k4[1]; kr[4 * i + 2] = k4[2]; kr[4 * i + 3] = k4[3]; }
#pragma unroll
            for (int i = 0; i < 32; ++i) { S[i] *= eg; kv += kr[i] * S[i]; }
            kv += __shfl_xor(kv, 1); kv += __shfl_xor(kv, 2);
            const float dl = (vv - kv) * beta; float o = 0.f;
#pragma unroll
            for (int i = 0; i < 8; ++i) { const f32x4 q4 = qp[i];
                S[4 * i] += kr[4 * i] * dl; S[4 * i + 1] += kr[4 * i + 1] * dl; S[4 * i + 2] += kr[4 * i + 2] * dl; S[4 * i + 3] += kr[4 * i + 3] * dl;
                o += q4[0] * S[4 * i] + q4[1] * S[4 * i + 1] + q4[2] * S[4 * i + 2] + q4[3] * S[4 * i + 3]; }
            o += __shfl_xor(o, 1); o += __shfl_xor(o, 2);
            if (kq == 0) os[t * 128 + vcol] = o;
        }
        __syncthreads();
        for (int t = wave; t < nt; t += NWAVES) { const int row = row_base + t0 + t; const float a = os[t * 128 + lane], b = os[t * 128 + 64 + lane];
            const float ss = wave_sum(a * a + b * b); const float rs = rsqrt_f(ss * (1.0f / 128.f) + EPS);
            const float za = bf2f(P.proj[(size_t)row * PROJ_LD + 3072 + h * 128 + lane]), zb = bf2f(P.proj[(size_t)row * PROJ_LD + 3072 + h * 128 + 64 + lane]);
            P.cat[(size_t)row * DM + h * 128 + lane] = (bf16)f2bf(a * rs * P.dn_norm[lane] * silu_f(za));
            P.cat[(size_t)row * DM + h * 128 + 64 + lane] = (bf16)f2bf(b * rs * P.dn_norm[64 + lane] * silu_f(zb)); }
        __syncthreads();
    }
#pragma unroll
    for (int i = 0; i < 32; ++i) Sout[(size_t)(32 * kq + i) * 128 + vcol] = S[i];
}


typedef short bf16x8 __attribute__((ext_vector_type(8)));
#define BAR_LDS() do { asm volatile("s_waitcnt lgkmcnt(0)" ::: "memory"); __builtin_amdgcn_s_barrier(); asm volatile("" ::: "memory"); } while (0)
__device__ __forceinline__ bf16x8 frag_lds(const LAS bf16* base, int ld, int row0, int k0, int lane) { return *(const LAS bf16x8*)(base + (row0 + (lane & 15)) * ld + k0 + 8 * (lane >> 4)); }
__device__ __forceinline__ bf16x8 frag_glb(const bf16* base, int ld, int row0, int k0, int lane) { return *(const bf16x8*)(base + (size_t)(row0 + (lane & 15)) * ld + k0 + 8 * (lane >> 4)); }
#define MMA16(a, b, c) __builtin_amdgcn_mfma_f32_16x16x32_bf16((a), (b), (c), 0, 0, 0)
constexpr int PLD = 136;
constexpr int MLD = 68;
struct PrepP { const bf16* proj; const float* ba; const float *conv_w, *a_log, *dt_bias; bf16 *dW, *dQG, *dQK, *dKD; float *dU, *dEGL; };
constexpr int PREP_LDS = 71680;
__device__ __forceinline__ float rdlane(float v, int l) { return __builtin_bit_cast(float, __builtin_amdgcn_readlane(__builtin_bit_cast(int, v), l)); }
__device__ __forceinline__ void prep_pair(LAS unsigned char* lds, const PrepP& P, int u0, int u1) {
    int tid_ = threadIdx.x; asm volatile("" : "+v"(tid_));
    const int tid = tid_, lane = tid & 63, wave = __builtin_amdgcn_readfirstlane(tid >> 6), g = wave >> 2, lw = wave & 3, lt = tid & 255;
    { unsigned lb_ = (unsigned)(size_t)lds + (unsigned)g * PREP_LDS; asm volatile("" : "+v"(lb_)); lds = (LAS unsigned char*)(size_t)lb_; }
    LAS bf16* Qr = (LAS bf16*)lds;
    LAS bf16* Kr = Qr + 64 * PLD;
    LAS float* Mf = (LAS float*)(Kr + 64 * PLD);
    LAS float* ssk = Mf + 64 * MLD; LAS float* ssq = ssk + 64;
    LAS float* rkv = ssq + 64; LAS float* rqv = rkv + 64;
    LAS float* sbeta = rqv + 64; LAS float* sgc = sbeta + 64; LAS float* segc = sgc + 64; LAS float* sekd = segc + 64;
    const int u = g ? u1 : u0, c = u & 31, bh = u >> 5, b = bh >> 3, h = bh & 7, row0 = b * SEQ + c * 64;
    const bool isk = lt < 128; const int cc = lt & 127, th = lt >> 7;
    typedef float f32x2 __attribute__((ext_vector_type(2)));
    f32x2 xp[32]; float xq[32];
#define X(t) xp[(t) >> 1][(t) & 1]
    if (lw == 3) {
        const float Ah = __expf(P.a_log[h]), dtb = P.dt_bias[h];
        const float braw = P.ba[(size_t)(row0 + lane) * 16 + h], araw = P.ba[(size_t)(row0 + lane) * 16 + 8 + h];
        const float beta = sigmoid_f(braw), gg = -Ah * softplus_f(araw + dtb);
        float gc = gg;
#pragma unroll
        for (int o = 1; o < 64; o <<= 1) { const float v = __shfl_up(gc, o); if (lane >= o) gc += v; }
        const float gl = __shfl(gc, 63);
        sbeta[lane] = beta; sgc[lane] = gc; segc[lane] = __expf(gc); sekd[lane] = __expf(gl - gc);
        if (lane == 0) P.dEGL[u] = __expf(gl);
    }
    {
        const int col = (isk ? 1024 : 2048) + h * 128 + cc;
        const float w0 = P.conv_w[col], w1 = P.conv_w[3072 + col], w2 = P.conv_w[2 * 3072 + col], w3 = P.conv_w[3 * 3072 + col];
        const bf16* pp = P.proj + (size_t)row0 * PROJ_LD + col;
        float pm3 = 0.f, pm2 = 0.f, pm1 = 0.f;
        if (c > 0) { pm3 = bf2f(pp[-3 * PROJ_LD]); pm2 = bf2f(pp[-2 * PROJ_LD]); pm1 = bf2f(pp[-1 * PROJ_LD]); }
#pragma unroll
        for (int t = 0; t < 64; ++t) { const float pc = bf2f(pp[(size_t)t * PROJ_LD]); X(t) = silu_f(w0 * pm3 + w1 * pm2 + w2 * pm1 + w3 * pc); pm3 = pm2; pm2 = pm1; pm1 = pc; }
        if (isk) {
#pragma unroll
            for (int t = 0; t < 64; ++t) Kr[t * PLD + cc] = (bf16)f2bf(X(t)); }
    }
    {
        const int col = h * 128 + cc;
        const float w0 = P.conv_w[col], w1 = P.conv_w[3072 + col], w2 = P.conv_w[2 * 3072 + col], w3 = P.conv_w[3 * 3072 + col];
        const bf16* pp = P.proj + (size_t)(row0 + 32 * th) * PROJ_LD + col;
        float pm3 = 0.f, pm2 = 0.f, pm1 = 0.f;
        if (c > 0 || th > 0) { pm3 = bf2f(pp[-3 * PROJ_LD]); pm2 = bf2f(pp[-2 * PROJ_LD]); pm1 = bf2f(pp[-1 * PROJ_LD]); }
#pragma unroll
        for (int t = 0; t < 32; ++t) { const float pc = bf2f(pp[(size_t)t * PROJ_LD]); xq[t] = silu_f(w0 * pm3 + w1 * pm2 + w2 * pm1 + w3 * pc); pm3 = pm2; pm2 = pm1; pm1 = pc;
            Qr[(32 * th + t) * PLD + cc] = (bf16)f2bf(xq[t]); }
    }
    BAR_LDS();
    const int fr = lane & 15, fq = lane >> 4;
    f32x4 tacc[6];
#pragma unroll
    for (int n = 0; n < 6; ++n) {
        const int e = lw * 6 + n, ty = e < 10 ? 0 : (e < 20 ? 1 : 2), pidx = ty == 0 ? e : (ty == 1 ? e - 10 : 0);
        const int ti = ty == 2 ? e - 20 : (pidx >= 6 ? 3 : (pidx >= 3 ? 2 : (pidx >= 1 ? 1 : 0))), tj = ty == 2 ? ti : pidx - ti * (ti + 1) / 2;
        const LAS bf16* Xa = ty == 0 ? Kr : Qr; const LAS bf16* Xb = ty == 2 ? Qr : Kr;
        f32x4 acc = (f32x4){0.f, 0.f, 0.f, 0.f};
#pragma unroll
        for (int ks = 0; ks < 4; ++ks) acc = MMA16(frag_lds(Xb, PLD, 16 * tj, 32 * ks, lane), frag_lds(Xa, PLD, 16 * ti, 32 * ks, lane), acc);
        tacc[n] = acc;
        if (ti == tj && ty != 1 && (fr >> 2) == fq) { const int jj = fr & 3; const float d = jj == 0 ? acc[0] : (jj == 1 ? acc[1] : (jj == 2 ? acc[2] : acc[3])); (ty == 0 ? ssk : ssq)[16 * ti + fr] = d; }
    }
    BAR_LDS();
    const float rk_l = rsqrt_f(ssk[lane] + EPS), rq_l = rsqrt_f(ssq[lane] + EPS) * 0.08838834764831845f, bet_l = sbeta[lane], egc_l = segc[lane];
    const float cq_l = rq_l * egc_l, ckd_l = rk_l * sekd[lane], ckb_l = rk_l * bet_l * egc_l;
    rkv[lane] = rk_l; rqv[lane] = rq_l;
    asm volatile("s_waitcnt lgkmcnt(0)" ::: "memory");
#pragma unroll
    for (int n = 0; n < 6; ++n) {
        const int e = lw * 6 + n, ty = e < 10 ? 0 : (e < 20 ? 1 : 2), pidx = ty == 0 ? e : (ty == 1 ? e - 10 : 0);
        const int ti = ty == 2 ? e - 20 : (pidx >= 6 ? 3 : (pidx >= 3 ? 2 : (pidx >= 1 ? 1 : 0))), tj = ty == 2 ? ti : pidx - ti * (ti + 1) / 2;
        if (ty < 2) {
            const int i = 16 * ti + fr, j0 = 16 * tj + 4 * fq; const float gi = sgc[i]; const float pre = ty == 0 ? sbeta[i] * rkv[i] : rqv[i];
            const f32x4 rj = *(const LAS f32x4*)(rkv + j0), gj = *(const LAS f32x4*)(sgc + j0);
            float o[4];
#pragma unroll
            for (int jj = 0; jj < 4; ++jj) { const int j = j0 + jj; const float dec = __expf(gi - gj[jj]); const bool keep = ty ? (i >= j) : (i > j); o[jj] = keep ? tacc[n][jj] * pre * rj[jj] * dec : 0.f; }
            if (ty) { v2u w; w.x = pk2(o[0], o[1]); w.y = pk2(o[2], o[3]); *(v2u*)(P.dQK + (size_t)u * 4096 + ((ti * 2 + (tj >> 1)) * 64 + ((2 * tj + (fq >> 1)) & 3) * 16 + fr) * 8 + 4 * (fq & 1)) = w; }
            else *(LAS f32x4*)(Mf + i * MLD + j0) = (f32x4){o[0], o[1], o[2], o[3]};
        }
    }
    {
#pragma unroll
        for (int n = 0; n < 3; ++n) { const int z = lw * 3 + n, ty = z / 6, p6 = z % 6;
            const int ti = p6 < 3 ? 0 : (p6 < 5 ? 1 : 2), tj = p6 < 3 ? p6 + 1 : (p6 < 5 ? p6 - 1 : 3);
            const int i = 16 * ti + fr, j0 = 16 * tj + 4 * fq;
            if (ty) { v2u w; w.x = 0u; w.y = 0u; *(v2u*)(P.dQK + (size_t)u * 4096 + ((ti * 2 + (tj >> 1)) * 64 + ((2 * tj + (fq >> 1)) & 3) * 16 + fr) * 8 + 4 * (fq & 1)) = w; }
            else *(LAS f32x4*)(Mf + i * MLD + j0) = (f32x4){0.f, 0.f, 0.f, 0.f}; }
    }
    if (isk) {
        bf16* kd = P.dKD + (size_t)u * 8192 + (size_t)(cc >> 4) * 1024 + (cc & 15) * 8;
        unsigned pk[32];
#pragma unroll
        for (int t = 0; t < 64; ++t) { const unsigned kdv = f2bf(X(t) * rdlane(ckd_l, t)); if (t & 1) pk[t >> 1] |= kdv << 16; else pk[t >> 1] = kdv; X(t) *= rdlane(ckb_l, t); }
#pragma unroll
        for (int i = 0; i < 8; ++i) { v4u o; o.x = pk[4 * i]; o.y = pk[4 * i + 1]; o.z = pk[4 * i + 2]; o.w = pk[4 * i + 3]; *(v4u*)(kd + (i >> 2) * 512 + (i & 3) * 128) = o; }
    } else {
#pragma unroll
        for (int t = 0; t < 64; ++t) X(t) *= rdlane(bet_l, t);
    }
    BAR_LDS();
#pragma unroll
    for (int i = 1; i < 64; ++i) { f32x2 a01 = (f32x2){X(i), 0.f}, a23 = (f32x2){0.f, 0.f};
#pragma unroll
        for (int jg = 0; 4 * jg < i; ++jg) { const f32x4 m = *(const LAS f32x4*)(Mf + i * MLD + 4 * jg);
            a01 -= (f32x2){m[0], m[1]} * xp[2 * jg]; a23 -= (f32x2){m[2], m[3]} * xp[2 * jg + 1]; }
        const f32x2 sm = a01 + a23; X(i) = sm[0] + sm[1]; }
    if (isk) {
#pragma unroll
        for (int t = 0; t < 64; ++t) Kr[t * PLD + cc] = (bf16)f2bf(X(t));
    } else { float* up = P.dU + (size_t)u * 8192 + (size_t)(cc >> 4) * 1024 + (cc & 15) * 4;
#pragma unroll
        for (int i = 0; i < 16; ++i) *(f32x4*)(up + (i >> 2) * 256 + (i & 3) * 64) = (f32x4){X(4 * i), X(4 * i + 1), X(4 * i + 2), X(4 * i + 3)}; }
#pragma unroll
    for (int t = 0; t < 32; ++t) { const int tt = 32 * th + t; Qr[tt * PLD + cc] = (bf16)f2bf(xq[t] * rdlane(cq_l, tt)); }
    BAR_LDS();
#pragma unroll
    for (int i = 0; i < 4; ++i) { const int pz = (lw * 4 + i) * 64 + lane; const int rb = pz >> 8, ks = (pz >> 6) & 3, t = rb * 16 + (lane & 15), d0 = ks * 32 + (lane >> 4) * 8;
        *(v4u*)(P.dW + (size_t)u * 8192 + (size_t)pz * 8) = *(const LAS v4u*)(Kr + t * PLD + d0);
        *(v4u*)(P.dQG + (size_t)u * 8192 + (size_t)pz * 8) = *(const LAS v4u*)(Qr + t * PLD + d0); }
    BAR_LDS();
}
#undef X
struct ScanP { const bf16 *dW, *dQG, *dQK, *dKD; const float *dU, *dEGL; float *ob, *ossq, *sout; };
constexpr int VLD = 72;
template <bool LOW>
__device__ __forceinline__ void scan_loop(LAS bf16* St, LAS bf16* Vt, const ScanP& P, int bh, int sl, int wave, int lane, f32x4& S) {
    const int fr = lane & 15, fq = lane >> 4, rb = wave & 3, e0 = sl * 16, b = bh / NH, h = bh % NH;
    const size_t u0 = (size_t)bh * (SEQ / 64);
    struct Ops { bf16x8 A1[4], K2[2], QK[2]; f32x4 Uv; float egl; };
    Ops R0, R1, R2, R3;
#define SCAN_LOAD(o, cc) do { const size_t u_ = u0 + ((cc) < SEQ / 64 ? (cc) : SEQ / 64 - 1); const bf16* a1 = (LOW ? P.dW : P.dQG) + u_ * 8192; \
        _Pragma("unroll") for (int ks = 0; ks < 4; ++ks) (o).A1[ks] = *(const bf16x8*)(a1 + ((rb * 4 + ks) * 64 + lane) * 8); \
        _Pragma("unroll") for (int ks = 0; ks < 2; ++ks) (o).K2[ks] = *(const bf16x8*)(P.dKD + u_ * 8192 + ((wave * 2 + ks) * 64 + lane) * 8); \
        if (LOW) (o).Uv = *(const f32x4*)(P.dU + u_ * 8192 + ((sl * 4 + rb) * 64 + lane) * 4); \
        else { _Pragma("unroll") for (int ks = 0; ks < 2; ++ks) (o).QK[ks] = *(const bf16x8*)(P.dQK + u_ * 4096 + ((rb * 2 + ks) * 64 + lane) * 8); } \
        (o).egl = P.dEGL[u_]; } while (0)
#define SCAN_STEP(cur, nxt, c) do { SCAN_LOAD(nxt, (c) + 3); \
        f32x4 acc = (f32x4){0.f, 0.f, 0.f, 0.f}; \
        _Pragma("unroll") for (int ks = 0; ks < 4; ++ks) acc = MMA16((cur).A1[ks], frag_lds(St, PLD, 0, 32 * ks, lane), acc); \
        if (LOW) { const f32x4 vn = (cur).Uv - acc; v2u w; w.x = pk2(vn[0], vn[1]); w.y = pk2(vn[2], vn[3]); *(LAS v2u*)(Vt + fr * VLD + 16 * rb + 4 * fq) = w; } \
        BAR_LDS(); \
        const bf16x8 v0 = frag_lds(Vt, VLD, 0, 0, lane), v1 = frag_lds(Vt, VLD, 0, 32, lane); \
        if (!LOW) { acc = MMA16((cur).QK[0], v0, acc); acc = MMA16((cur).QK[1], v1, acc); \
            const int row = b * SEQ + (c) * 64 + 16 * rb + 4 * fq; float* op = P.ob + (size_t)row * DNW + h * 128 + e0 + fr; \
            _Pragma("unroll") for (int j = 0; j < 4; ++j) __hip_atomic_store(op + (size_t)j * DNW, acc[j], __ATOMIC_RELAXED, __HIP_MEMORY_SCOPE_AGENT); }     \
        S = S * (cur).egl; S = MMA16((cur).K2[0], v0, S); S = MMA16((cur).K2[1], v1, S); \
        { v2u w; w.x = pk2(S[0], S[1]); w.y = pk2(S[2], S[3]); *(LAS v2u*)(St + fr * PLD + 16 * wave + 4 * fq) = w; } \
        BAR_LDS(); } while (0)
    SCAN_LOAD(R0, 0); SCAN_LOAD(R1, 1); SCAN_LOAD(R2, 2);
    for (int c0 = 0; c0 < SEQ / 64; c0 += 4) { SCAN_STEP(R0, R3, c0); SCAN_STEP(R1, R0, c0 + 1); SCAN_STEP(R2, R1, c0 + 2); SCAN_STEP(R3, R2, c0 + 3); }
#undef SCAN_STEP
#undef SCAN_LOAD
}
__device__ __forceinline__ void scan_item(LAS unsigned char* lds, const ScanP& P, int bh, int sl) {
    LAS bf16* St = (LAS bf16*)lds;
    LAS bf16* Vt = St + 16 * PLD;
    int tid_ = threadIdx.x; asm volatile("" : "+v"(tid_));
    const int tid = tid_, lane = tid & 63, wave = __builtin_amdgcn_readfirstlane(tid >> 6), fr = lane & 15, fq = lane >> 4;
    for (int i = tid; i < 16 * PLD / 2; i += NTHR) ((LAS unsigned*)St)[i] = 0u;
    f32x4 S = (f32x4){0.f, 0.f, 0.f, 0.f};
    BAR_LDS();
    if (wave < 4) scan_loop<true>(St, Vt, P, bh, sl, wave, lane, S); else scan_loop<false>(St, Vt, P, bh, sl, wave, lane, S);
    float* so = P.sout + (size_t)bh * 16384 + (size_t)(16 * wave + 4 * fq) * 128 + sl * 16 + fr;
#pragma unroll
    for (int j = 0; j < 4; ++j) so[j * 128] = S[j];
}

constexpr int SK_SLOT = 20480;
__device__ __forceinline__ void skinny2_mma(LAS unsigned char* lds, const bf16* A, int lda, const bf16* Bt, int ldb, int K, int brow0, int brow1, f32x4 (&acc)[2]) {
    int tid_ = threadIdx.x; asm volatile("" : "+v"(tid_));
    const int tid = tid_, lane = tid & 63, wave = __builtin_amdgcn_readfirstlane(tid >> 6), fr = lane & 15, fq = lane >> 4;
    unsigned voffA[2], voffB;
#pragma unroll
    for (int i = 0; i < 2; ++i) { int R, C; pg8::stage_rc(tid * 16 + i * 8192, R, C); voffA[i] = (unsigned)(R * lda + C) * 2u; }
    { int R, C; pg8::stage_rc((tid & 255) * 16, R, C); voffB = (unsigned)((R < 16 ? brow0 + R : brow1 + R - 16) * ldb + C) * 2u; }
    const unsigned ldswA = (unsigned)wave * 1024u, ldswB = 16384u + (unsigned)(wave & 3) * 1024u;
    int aoff[2], boff[2][2];
#pragma unroll
    for (int ks = 0; ks < 2; ++ks) { aoff[ks] = pg8::lds_byte(16 * wave + fr, 32 * ks + 8 * fq); boff[0][ks] = 16384 + pg8::lds_byte(fr, 32 * ks + 8 * fq); boff[1][ks] = 16384 + pg8::lds_byte(16 + fr, 32 * ks + 8 * fq); }
    const int nt = K / 64;
#define SK_STAGE(kt_, slot_) do { const char* ga = (const char*)A + (size_t)(kt_) * 128; const char* gb = (const char*)Bt + (size_t)(kt_) * 128; LAS unsigned char* sl_ = lds + (slot_) * SK_SLOT; \
        _Pragma("unroll") for (int _i = 0; _i < 2; ++_i) { unsigned vo = voffA[_i]; asm volatile("" : "+v"(vo)); __builtin_amdgcn_global_load_lds((const unsigned*)(ga + vo), (LAS unsigned*)(sl_ + ldswA + _i * 8192), 16, 0, 0); } \
        { unsigned vo = voffB; asm volatile("" : "+v"(vo)); __builtin_amdgcn_global_load_lds((const unsigned*)(gb + vo), (LAS unsigned*)(sl_ + ldswB), 16, 0, 0); } } while (0)
    acc[0] = (f32x4){0.f, 0.f, 0.f, 0.f}; acc[1] = (f32x4){0.f, 0.f, 0.f, 0.f};
    SK_STAGE(0, 0); SK_STAGE(1, 1); SK_STAGE(2, 2);
    for (int kt = 0; kt < nt; ++kt) {
        asm volatile("s_waitcnt vmcnt(6)" ::: "memory");
        __builtin_amdgcn_s_barrier(); asm volatile("" ::: "memory");
        { const int k3 = kt + 3 < nt ? kt + 3 : 0; SK_STAGE(k3, (kt + 3) & 3); }
        const LAS unsigned char* sl = lds + (kt & 3) * SK_SLOT;
#pragma unroll
        for (int ks = 0; ks < 2; ++ks) { const bf16x8 a = *(const LAS bf16x8*)(sl + aoff[ks]), b0 = *(const LAS bf16x8*)(sl + boff[0][ks]), b1 = *(const LAS bf16x8*)(sl + boff[1][ks]);
            acc[0] = MMA16(b0, a, acc[0]); acc[1] = MMA16(b1, a, acc[1]); }
        asm volatile("s_waitcnt lgkmcnt(0)" ::: "memory");
    }
    asm volatile("s_waitcnt vmcnt(0)" ::: "memory");
    __builtin_amdgcn_s_barrier(); asm volatile("" ::: "memory");
#undef SK_STAGE
}
__device__ __forceinline__ void short_blocks(int nwg, int G, int c, int& si, int& nshort) {
    const int rounds = (nwg + G - 1) / G, full = nwg - (rounds - 1) * G;
    if (full == G) { nshort = G; si = c; } else { nshort = G - full; si = c - full; }
}
__device__ __forceinline__ float dec_row_scale(const float* dssq, int r) {
    const f32x4* p = (const f32x4*)(dssq + (size_t)r * 64); float s = 0.f;
#pragma unroll
    for (int i = 0; i < 16; ++i) { const f32x4 v = p[i]; s += (v[0] + v[1]) + (v[2] + v[3]); }
    return rsqrt_f(s * (1.0f / DM) + EPS);
}
constexpr int SK8_SLOT = 32768;
template <bool GU>
__device__ __forceinline__ void skinny128_mma(LAS unsigned char* lds, const bf16* A, int lda, const bf16* Bt, int ldb, int K, int brow0, f32x4 (&acc)[8]) {
    int tid_ = threadIdx.x; asm volatile("" : "+v"(tid_));
    const int tid = tid_, lane = tid & 63, wave = __builtin_amdgcn_readfirstlane(tid >> 6), fr = lane & 15, fq = lane >> 4;
    unsigned voffA[2], voffB[2];
#pragma unroll
    for (int i = 0; i < 2; ++i) { int R, C; pg8::stage_rc(tid * 16 + i * 8192, R, C); voffA[i] = (unsigned)(R * lda + C) * 2u;
        const int rowb = GU ? (R < 64 ? brow0 + R : brow0 + 128 + (R - 64)) : brow0 + R; voffB[i] = (unsigned)(rowb * ldb + C) * 2u; }
    const unsigned ldsw = (unsigned)wave * 1024u;
    int aoff[2], boff[2];
#pragma unroll
    for (int ks = 0; ks < 2; ++ks) { aoff[ks] = pg8::lds_byte(16 * wave + fr, 32 * ks + 8 * fq); boff[ks] = 16384 + pg8::lds_byte(fr, 32 * ks + 8 * fq); }
    const int nt = K / 64;
#define SK8_STAGE(kt_, slot_) do { const char* ga = (const char*)A + (size_t)(kt_) * 128; const char* gb = (const char*)Bt + (size_t)(kt_) * 128; LAS unsigned char* sl_ = lds + (slot_) * SK8_SLOT; \
        _Pragma("unroll") for (int _i = 0; _i < 2; ++_i) { unsigned vo = voffA[_i]; asm volatile("" : "+v"(vo)); __builtin_amdgcn_global_load_lds((const unsigned*)(ga + vo), (LAS unsigned*)(sl_ + ldsw + _i * 8192), 16, 0, 0); } \
        _Pragma("unroll") for (int _i = 0; _i < 2; ++_i) { unsigned vo = voffB[_i]; asm volatile("" : "+v"(vo)); __builtin_amdgcn_global_load_lds((const unsigned*)(gb + vo), (LAS unsigned*)(sl_ + 16384 + ldsw + _i * 8192), 16, 0, 0); } } while (0)
#pragma unroll
    for (int nb = 0; nb < 8; ++nb) acc[nb] = (f32x4){0.f, 0.f, 0.f, 0.f};
    SK8_STAGE(0, 0); SK8_STAGE(1, 1); SK8_STAGE(2, 2);
    for (int kt = 0; kt < nt; ++kt) {
        asm volatile("s_waitcnt vmcnt(8)" ::: "memory");
        __builtin_amdgcn_s_barrier(); asm volatile("" ::: "memory");
        { const int k3 = kt + 3 < nt ? kt + 3 : 0; SK8_STAGE(k3, (kt + 3) & 3); }
        const LAS unsigned char* sl = lds + (kt & 3) * SK8_SLOT;
#pragma unroll
        for (int ks = 0; ks < 2; ++ks) { const bf16x8 a = *(const LAS bf16x8*)(sl + aoff[ks]);
#pragma unroll
            for (int nb = 0; nb < 8; ++nb) { const bf16x8 bq = *(const LAS bf16x8*)(sl + boff[ks] + nb * 2048); acc[nb] = MMA16(bq, a, acc[nb]); } }
        asm volatile("s_waitcnt lgkmcnt(0)" ::: "memory");
    }
    asm volatile("s_waitcnt vmcnt(0)" ::: "memory");
    __builtin_amdgcn_s_barrier(); asm volatile("" ::: "memory");
#undef SK8_STAGE
}
__device__ __forceinline__ void dec_in_tiles(LAS unsigned char* lds, const bf16* HB, const bf16* Bt, bf16* proj, float* ba, const float* dssq, int si, int nshort) {
    if (si < 0) return;
    int tl = threadIdx.x; asm volatile("" : "+v"(tl)); const int lane = tl & 63, wave = __builtin_amdgcn_readfirstlane(tl >> 6), r = 16 * wave + (lane & 15), q = lane >> 4;
    for (int t = si; t < 41; t += nshort) {
        f32x4 acc[8];
        skinny128_mma<false>(lds, HB + (size_t)MP * DM, DM, Bt, DM, DM, 128 * t, acc);
        const float rs = dec_row_scale(dssq, r);
        if (t < 40) {
#pragma unroll
            for (int nb = 0; nb < 8; ++nb) { const f32x4 v = acc[nb] * rs; v2u w; w.x = pk2(v[0], v[1]); w.y = pk2(v[2], v[3]); *(v2u*)(proj + (size_t)(MP + r) * PROJ_LD + 128 * t + 16 * nb + 4 * q) = w; }
        } else *(f32x4*)(ba + (size_t)(MP + r) * 16 + 4 * q) = acc[0] * rs;
    }
}
__device__ __forceinline__ void dec_res_tiles(LAS unsigned char* lds, const bf16* A, int K, const bf16* Bt, bf16* hb, float* dssq, int si, int nshort) {
    if (si < 0) return;
    int tl = threadIdx.x; asm volatile("" : "+v"(tl)); const int lane = tl & 63, wave = __builtin_amdgcn_readfirstlane(tl >> 6), r = 16 * wave + (lane & 15), q = lane >> 4;
    for (int t = si; t < 64; t += nshort) {
        f32x4 acc[2];
        skinny2_mma(lds, A + (size_t)MP * K, K, Bt, K, K, 32 * t, 32 * t + 16, acc);
        float sq = 0.f;
#pragma unroll
        for (int nb = 0; nb < 2; ++nb) { bf16* hp = hb + (size_t)(MP + r) * DM + 32 * t + 16 * nb + 4 * q; const v2u o = *(const v2u*)hp; f32x4 v = acc[nb];
            v[0] += __builtin_bit_cast(float, o.x << 16); v[1] += __builtin_bit_cast(float, o.x & 0xffff0000u); v[2] += __builtin_bit_cast(float, o.y << 16); v[3] += __builtin_bit_cast(float, o.y & 0xffff0000u);
            v2u w; w.x = pk2(v[0], v[1]); w.y = pk2(v[2], v[3]); *(v2u*)hp = w;
            sq += (v[0] * v[0] + v[1] * v[1]) + (v[2] * v[2] + v[3] * v[3]); }
        sq += __shfl_xor(sq, 16); sq += __shfl_xor(sq, 32);
        if (q == 0) dssq[(size_t)r * 64 + t] = sq;
    }
}
__device__ __forceinline__ void dec_gu_tiles(LAS unsigned char* lds, const bf16* HB, const bf16* Bt, bf16* act, const float* dssq, int si, int nshort) {
    if (si < 0) return;
    int tl = threadIdx.x; asm volatile("" : "+v"(tl)); const int lane = tl & 63, wave = __builtin_amdgcn_readfirstlane(tl >> 6), r = 16 * wave + (lane & 15), q = lane >> 4;
    for (int t = si; t < DFF / 64; t += nshort) {
        const int c0 = 64 * t, g0 = (c0 >> 7) * 256 + (c0 & 127); f32x4 acc[8];
        skinny128_mma<true>(lds, HB + (size_t)MP * DM, DM, Bt, DM, DM, g0, acc);
        const float rs = dec_row_scale(dssq, r);
#pragma unroll
        for (int nb = 0; nb < 4; ++nb) { const f32x4 gt = acc[nb] * rs, up = acc[nb + 4] * rs;
            v2u w; w.x = pk2(silu_f(gt[0]) * up[0], silu_f(gt[1]) * up[1]); w.y = pk2(silu_f(gt[2]) * up[2], silu_f(gt[3]) * up[3]);
            *(v2u*)(act + (size_t)(MP + r) * DFF + c0 + 16 * nb + 4 * q) = w; }
    }
}

#ifndef AL_IN
#define AL_IN true
#define SP_IN true
#define AL_POOL true
#define SP_POOL true
#define AL_RES true
#define SP_RES true
#define AL_GU true
#define SP_GU true
#endif
__device__ __forceinline__ void ph_gemm_in(LAS unsigned char* lds, const bf16* A, const bf16* Bt, bf16* proj, float* ba, const float* ssq, int G, int bid) {
    pg8::Gemm g{A, Bt, MP, NIN, DM, DM, DM, 0}; pg8::StaticOrder S; S.init(MP, NIN, G, bid); EpiIn E{proj, ba, ssq};
    pg8::gemm_phase<EpiIn, pg8::StaticOrder, AL_IN, SP_IN>(lds, g, S, E);
}
__device__ __forceinline__ void ph_gemm_pool(LAS unsigned char* lds, const bf16* A, const bf16* Bt, bf16* cat, const float* scale, int G, int bid) {
    pg8::Gemm g{A, Bt, MPAD, 1024, 256, POOLW, 256, 512}; pg8::StaticOrder S; S.init(MPAD, 1024, G, bid); EpiPool E{cat, scale};
    pg8::gemm_phase<EpiPool, pg8::StaticOrder, AL_POOL, SP_POOL>(lds, g, S, E);
}
__device__ __forceinline__ void ph_gemm_res(LAS unsigned char* lds, const bf16* A, const bf16* Bt, int K, bf16* hb, float* ssq, int G, int bid) {
    pg8::Gemm g{A, Bt, MP, DM, K, K, K, 0}; pg8::StaticOrder S; S.init(MP, DM, G, bid); EpiRes E{hb, ssq};
    pg8::gemm_phase<EpiRes, pg8::StaticOrder, AL_RES, SP_RES>(lds, g, S, E);
}
__device__ __forceinline__ void ph_gemm_gu(LAS unsigned char* lds, const bf16* A, const bf16* Bt, bf16* act, const float* ssq, int G, int bid) {
    pg8::Gemm g{A, Bt, MP, 2 * DFF, DM, DM, DM, 0}; pg8::StaticOrder S; S.init(MP, 2 * DFF, G, bid); EpiSwiGLU E{act, ssq};
    pg8::gemm_phase<EpiSwiGLU, pg8::StaticOrder, AL_GU, SP_GU>(lds, g, S, E);
}

constexpr int N_PHASES = 2 + 6 * DEPTH;
typedef const Args __attribute__((address_space(4)))* KArgs;
__device__ __forceinline__ KArgs kargs_() { KArgs p = (KArgs)__builtin_amdgcn_kernarg_segment_ptr(); asm volatile("" : "+s"(p)); return p; }
#define KA (kargs_())
#define IN(k) (lo <= (k) && (k) < hi)
#define SEAM(k) do { if (IN(k) && IN((k) + 1)) { XcdBarrier bar_; bar_.bar = (unsigned*)(KA->ws + WS_CTL) + CW_BAR; bar_.x = xb_xcc_id(); bar_.st = (volatile LAS unsigned*)(lds + MISC_OFF) + 8; xcd_barrier(bar_); } } while (0)
#define WSP(T, off) ((T*)(ka->ws + (off)))
#define PHASE_PTRS() const KArgs ka = KA; bf16* const WinT = WSP(bf16, WS_WIN); bf16* const WoutT = WSP(bf16, WS_WOUT); bf16* const WguT = WSP(bf16, WS_WGU); bf16* const WdT = WSP(bf16, WS_WD); bf16* const WpT = WSP(bf16, WS_WP); \
    float* const H = WSP(float, WS_H); bf16* const HB = WSP(bf16, WS_HB); bf16* const PROJ = WSP(bf16, WS_PROJ); float* const BA = WSP(float, WS_BA); \
    bf16* const CAT = WSP(bf16, WS_CAT); bf16* const DB = WSP(bf16, WS_DB); bf16* const ACT = WSP(bf16, WS_ACT); float* const SSQ = WSP(float, WS_SSQ); \
    (void)WinT; (void)WoutT; (void)WguT; (void)WdT; (void)WpT; (void)H; (void)HB; (void)PROJ; (void)BA; (void)CAT; (void)DB; (void)ACT; (void)SSQ
template <int l> __device__ __forceinline__ void layer_phases(LAS unsigned char* lds, const int lo, const int hi, const int G, const int bid) {
        const int p0 = 1 + 6 * l;
        if (IN(p0)) {
            PHASE_PTRS();
            ph_gemm_in(lds, HB, WinT + (size_t)l * NIN * DM, PROJ, BA, SSQ, G, bid);
            { int si, ns; short_blocks((MP / 256) * (NIN / 256), G, bid, si, ns); dec_in_tiles(lds, HB, WinT + (size_t)l * NIN * DM, PROJ, BA, WSP(float, WS_DSSQ), si, ns);
              if (l + 1 < DEPTH && G == 256) { const CvP CV{ka->w_in, ka->norm_mix, ka->w_out, ka->w_gate_up, ka->norm_ffn, ka->w_down, ka->w_pool, WinT, WoutT, WguT, WdT, WpT}; convert_tail(CV, lds, l + 1, 0, si, ns, CV_A); } }
        }
        SEAM(p0);
        if (IN(p0 + 1)) {
            PHASE_PTRS();
            {
                PrepP PP{PROJ, BA, ka->conv_w + (size_t)l * 4 * 3072, ka->a_log + l * NH, ka->dt_bias + l * NH, WSP(bf16, WS_DW), WSP(bf16, WS_DQG), WSP(bf16, WS_DQK), WSP(bf16, WS_DKD), WSP(float, WS_DU), WSP(float, WS_EGL)};
                for (int u = bid; u < NUNIT; u += 2 * G) prep_pair(lds, PP, u, u + G < NUNIT ? u + G : u);
            }
            {
                MixP P{PROJ, BA, CAT, ka->conv_w + (size_t)l * 4 * 3072, ka->a_log + l * NH, ka->dt_bias + l * NH, ka->dn_norm + l * HD};
                const int wb = bid, nW = G;
                for (int it = wb; it < DECB * NH; it += nW) { const int b = it / NH, h = it % NH;
                    delta_seq(lds, P, MP + b, 1, h, ka->state_delta + ((size_t)(l * DECB + b) * NH + h) * 16384, ka->state_conv + (size_t)(l * DECB + b) * 3 * 3072, ka->out + O_DS + ((size_t)(l * DECB + b) * NH + h) * 16384); }
                int tl = threadIdx.x; asm volatile("" : "+v"(tl));
                const size_t gt = (size_t)wb * NTHR + tl, gs = (size_t)nW * NTHR;
                for (size_t it = gt; it < (size_t)(MP / 64) * POOLW; it += gs) {
                    const int c = (int)(it & 1023), chunk = (int)(it >> 10), rowb = chunk * 64, t0 = (chunk & 31) * 64, grp = c >> 8;
                    const bf16* pp = PROJ + (size_t)rowb * PROJ_LD + 4096 + c; bf16* dp = DB + (size_t)rowb * POOLW + c;
                    float w[16];
                    w[0] = 0.f;
#pragma unroll
                    for (int j = 0; j < 15; ++j) w[j + 1] = (t0 > 0) ? bf2f(pp[(long)(j - 15) * PROJ_LD]) : 0.f;
#pragma unroll
                    for (int t = 0; t < 64; ++t) {
                        w[t & 15] = bf2f(pp[(size_t)t * PROJ_LD]);
                        const float s2 = w[t & 15] + w[(t - 1) & 15];
                        const float s4 = s2 + (w[(t - 2) & 15] + w[(t - 3) & 15]);
                        const float s8 = s4 + ((w[(t - 4) & 15] + w[(t - 5) & 15]) + (w[(t - 6) & 15] + w[(t - 7) & 15]));
                        const float s16 = s8 + (((w[(t - 8) & 15] + w[(t - 9) & 15]) + (w[(t - 10) & 15] + w[(t - 11) & 15])) + ((w[(t - 12) & 15] + w[(t - 13) & 15]) + (w[(t - 14) & 15] + w[(t - 15) & 15])));
                        const float ssum = grp == 0 ? s2 : (grp == 1 ? s4 : (grp == 2 ? s8 : s16)); const int win = 2 << grp;
                        const int n = (t0 + t + 1) < win ? (t0 + t + 1) : win;
                        dp[(size_t)t * POOLW] = (bf16)f2bf(ssum / (float)n - w[t & 15]);
                    }
                }
                for (size_t idx = gt; idx < (size_t)DECB * POOLW; idx += gs) {
                    const int b = (int)(idx >> 10), c = (int)(idx & 1023), win = 2 << (c >> 8), row = MP + b;
                    const float cur = bf2f(PROJ[(size_t)row * PROJ_LD + 4096 + c]); const float* sp = ka->state_pool + (size_t)(l * DECB + b) * 15 * 1024; float sacc = cur;
                    for (int j = 1; j < win; ++j) sacc += sp[(15 - j) * 1024 + c];
                    DB[(size_t)row * POOLW + c] = (bf16)f2bf(sacc / (float)win - cur);
                }
                for (size_t idx = gt; idx < (size_t)NB * 3 * 3072; idx += gs) { const int b = (int)(idx / 9216), r = (int)(idx % 9216), i = r / 3072, c = r % 3072;
                    ka->out[O_CP + (size_t)(l * NB + b) * 9216 + r] = bf2f(PROJ[(size_t)(b * SEQ + SEQ - 3 + i) * PROJ_LD + c]); }
                for (size_t idx = gt; idx < (size_t)NB * 15 * 1024; idx += gs) { const int b = (int)(idx / 15360), r = (int)(idx % 15360), i = r / 1024, c = r % 1024;
                    ka->out[O_PP + (size_t)(l * NB + b) * 15360 + r] = bf2f(PROJ[(size_t)(b * SEQ + SEQ - 15 + i) * PROJ_LD + 4096 + c]); }
                for (size_t idx = gt; idx < (size_t)DECB * 3 * 3072; idx += gs) { const int b = (int)(idx / 9216), r = (int)(idx % 9216), i = r / 3072, c = r % 3072;
                    ka->out[O_CS + (size_t)(l * DECB + b) * 9216 + r] = i < 2 ? ka->state_conv[(size_t)(l * DECB + b) * 9216 + (i + 1) * 3072 + c] : bf2f(PROJ[(size_t)(MP + b) * PROJ_LD + c]); }
                for (size_t idx = gt; idx < (size_t)DECB * 15 * 1024; idx += gs) { const int b = (int)(idx / 15360), r = (int)(idx % 15360), i = r / 1024, c = r % 1024;
                    ka->out[O_PS + (size_t)(l * DECB + b) * 15360 + r] = i < 14 ? ka->state_pool[(size_t)(l * DECB + b) * 15360 + (i + 1) * 1024 + c] : bf2f(PROJ[(size_t)(MP + b) * PROJ_LD + 4096 + c]); }
            }
        }
        SEAM(p0 + 1);
        if (IN(p0 + 2)) {
            PHASE_PTRS();
            ScanP SP{WSP(bf16, WS_DW), WSP(bf16, WS_DQG), WSP(bf16, WS_DQK), WSP(bf16, WS_DKD), WSP(float, WS_DU), WSP(float, WS_EGL), WSP(float, WS_OB), WSP(float, WS_OSSQ), ka->out + O_DP + (size_t)l * NB * NH * 16384};
            unsigned* cnt = (unsigned*)(ka->ws + WS_CTL) + CW_SCAN + l * 32 * 64;
            for (int it = bid; it < NB * NH * 8; it += G) { scan_item(lds, SP, it & 31, it >> 5);
                asm volatile("s_waitcnt vmcnt(0)" ::: "memory"); __syncthreads();
                if (threadIdx.x == 0) __hip_atomic_fetch_add(cnt + (it & 31) * 64, 1u, __ATOMIC_RELAXED, __HIP_MEMORY_SCOPE_AGENT); }
            ph_gemm_pool(lds, DB, WpT + (size_t)l * 4 * 65536, CAT, ka->pool_scale + l * POOLW, G, bid);
            {
                int tl = threadIdx.x; asm volatile("" : "+v"(tl)); const int lane = tl & 63, wave = __builtin_amdgcn_readfirstlane(tl >> 6);
                const float* ob = WSP(float, WS_OB); const float* dn = ka->dn_norm + l * HD;
                const float dn0 = dn[lane], dn1 = dn[64 + lane];
                for (int it = bid; it < NB * NH * 8; it += G) { const int bh = it & 31, sl = it >> 5, b = bh >> 3, h = bh & 7;
                    if (threadIdx.x == 0) { unsigned sp = 0;
                        while (__hip_atomic_load(cnt + bh * 64, __ATOMIC_RELAXED, __HIP_MEMORY_SCOPE_AGENT) < 8u) { __builtin_amdgcn_s_sleep(1); if (++sp > (1u << 22)) break; }
                        __builtin_amdgcn_fence(__ATOMIC_ACQUIRE, "agent"); asm volatile("s_waitcnt vmcnt(0)" ::: "memory"); }
                    __syncthreads();
                    for (int tb = 0; tb < 256; tb += 8 * NWAVES) {
                        float a0[8], a1[8]; bf16 z0[8], z1[8];
#pragma unroll
                        for (int i = 0; i < 8; ++i) { const int row = b * SEQ + sl * 256 + tb + i * NWAVES + wave;
                            a0[i] = ob[(size_t)row * DNW + h * 128 + lane]; a1[i] = ob[(size_t)row * DNW + h * 128 + 64 + lane];
                            z0[i] = PROJ[(size_t)row * PROJ_LD + 3072 + h * 128 + lane]; z1[i] = PROJ[(size_t)row * PROJ_LD + 3072 + h * 128 + 64 + lane]; }
#pragma unroll
                        for (int i = 0; i < 8; ++i) { const int row = b * SEQ + sl * 256 + tb + i * NWAVES + wave;
                            const float ss = wave_sum(a0[i] * a0[i] + a1[i] * a1[i]); const float rs = rsqrt_f(ss * (1.0f / 128.f) + EPS);
                            CAT[(size_t)row * DM + h * 128 + lane] = (bf16)f2bf(a0[i] * rs * dn0 * silu_f(bf2f(z0[i])));
                            CAT[(size_t)row * DM + h * 128 + 64 + lane] = (bf16)f2bf(a1[i] * rs * dn1 * silu_f(bf2f(z1[i]))); }
                    }
                }
            }
        }
        SEAM(p0 + 2);
        if (IN(p0 + 3)) {
            PHASE_PTRS();
            ph_gemm_res(lds, CAT, WoutT + (size_t)l * DM * DM, DM, HB, SSQ, G, bid);
            { int si, ns; short_blocks((MP / 256) * (DM / 256), G, bid, si, ns); dec_res_tiles(lds, CAT, DM, WoutT + (size_t)l * DM * DM, HB, WSP(float, WS_DSSQ), si, ns); }
        }
        SEAM(p0 + 3);
        if (IN(p0 + 4)) {
            PHASE_PTRS();
            ph_gemm_gu(lds, HB, WguT + (size_t)l * 2 * DFF * DM, ACT, SSQ, G, bid);
            { int si, ns; short_blocks((MP / 256) * (2 * DFF / 256), G, bid, si, ns); dec_gu_tiles(lds, HB, WguT + (size_t)l * 2 * DFF * DM, ACT, WSP(float, WS_DSSQ), si, ns);
              if (l + 1 < DEPTH && G == 256) { const CvP CV{ka->w_in, ka->norm_mix, ka->w_out, ka->w_gate_up, ka->norm_ffn, ka->w_down, ka->w_pool, WinT, WoutT, WguT, WdT, WpT}; convert_tail(CV, lds, l + 1, CV_A, si, ns, CV_B); } }
        }
        SEAM(p0 + 4);
        if (IN(p0 + 5)) {
            PHASE_PTRS();
            ph_gemm_res(lds, ACT, WdT + (size_t)l * DM * DFF, DFF, HB, SSQ, G, bid);
            { int si, ns; short_blocks((MP / 256) * (DM / 256), G, bid, si, ns); dec_res_tiles(lds, ACT, DFF, WdT + (size_t)l * DM * DFF, HB, WSP(float, WS_DSSQ), si, ns); }
        }
        SEAM(p0 + 5);
    }
__global__ void __launch_bounds__(NTHR, 2) fwd(Args a) {
    extern __shared__ __attribute__((aligned(16))) unsigned char lds_raw[];
    LAS unsigned char* lds = (LAS unsigned char*)lds_raw;
    volatile LAS unsigned* MISC = (volatile LAS unsigned*)(lds + MISC_OFF);
    const int tid = threadIdx.x, lane = tid & 63, wave = __builtin_amdgcn_readfirstlane(tid >> 6);
    const int G = gridDim.x, bid = blockIdx.x;
    unsigned* ctl = (unsigned*)(KA->ws + WS_CTL);
    if (tid < 32) MISC[tid] = 0u;
    __syncthreads();
    const int lo = KA->ph_lo, hi = KA->ph_hi;
    if (hi - lo > 1) (void)xcd_barrier_post(ctl + CW_BAR, MISC + 8);

    const int gw = bid * NWAVES + wave, NGW = G * NWAVES;

    if (IN(0)) {
        PHASE_PTRS();
        int tl = threadIdx.x; asm volatile("" : "+v"(tl)); const int lane = tl & 63, wave = __builtin_amdgcn_readfirstlane(tl >> 6), gw = bid * NWAVES + wave;
        LAS float* scr = (LAS float*)(lds + wave * 16384);
        const CvP CV{ka->w_in, ka->norm_mix, ka->w_out, ka->w_gate_up, ka->norm_ffn, ka->w_down, ka->w_pool, WinT, WoutT, WguT, WdT, WpT};
        const int skip = (G == 256) ? CV_A + CV_B : 0;
        for (int it = gw; it < DEPTH * I_L; it += NGW) {
            const int l = it / I_L, r = it - l * I_L;
            if (l > 0 && r < skip) continue;
            convert_item(CV, l, r, scr, lane);
        }
        for (int m = gw; m < MPAD; m += NGW) {
            const float* src = m < MP ? ka->x_prompt + (size_t)m * DM : (m < MR ? ka->x_sample + (size_t)(m - MP) * DM : nullptr);
            float s = 0.f;
#pragma unroll
            for (int j = 0; j < 8; ++j) { f32x4 v = src ? *((const f32x4*)src + lane + 64 * j) : (f32x4){0.f, 0.f, 0.f, 0.f};
                s += (v[0] * v[0] + v[1] * v[1]) + (v[2] * v[2] + v[3] * v[3]);
                v2u w; w.x = pk2(v[0], v[1]); w.y = pk2(v[2], v[3]); *((v2u*)(HB + (size_t)m * DM) + lane + 64 * j) = w; }
            s = wave_sum(s);
            if (lane < 32) SSQ[(size_t)m * 32 + lane] = lane == 0 ? s : 0.f;
            if (m >= MP && m < MR) WSP(float, WS_DSSQ)[(size_t)(m - MP) * 64 + lane] = lane == 0 ? s : 0.f;
        }
    }
    SEAM(0);

    layer_phases<0>(lds, lo, hi, G, bid);
    layer_phases<1>(lds, lo, hi, G, bid);
    layer_phases<2>(lds, lo, hi, G, bid);
    layer_phases<3>(lds, lo, hi, G, bid);
    if (IN(N_PHASES - 1)) {
        PHASE_PTRS();
        int tl = threadIdx.x; asm volatile("" : "+v"(tl)); const int lane = tl & 63, gw = bid * NWAVES + __builtin_amdgcn_readfirstlane(tl >> 6);
        for (int m = gw; m < MR; m += NGW) {
            float r;
            if (m < MP) { const f32x4* p = (const f32x4*)(SSQ + (size_t)m * 32); float s = 0.f;
#pragma unroll
                for (int j = 0; j < 8; ++j) { const f32x4 v = p[j]; s += (v[0] + v[1]) + (v[2] + v[3]); }
                r = rsqrt_f(s * (1.0f / DM) + EPS); }
            else r = dec_row_scale(WSP(float, WS_DSSQ), m - MP);
#pragma unroll
            for (int j = 0; j < 8; ++j) { const v2u hv = *((const v2u*)(HB + (size_t)m * DM) + lane + 64 * j); const f32x4 w = *((const f32x4*)ka->norm_final + lane + 64 * j);
                const f32x4 v = (f32x4){__builtin_bit_cast(float, hv.x << 16), __builtin_bit_cast(float, hv.x & 0xffff0000u), __builtin_bit_cast(float, hv.y << 16), __builtin_bit_cast(float, hv.y & 0xffff0000u)};
                *((f32x4*)(ka->out + O_YP + (size_t)m * DM) + lane + 64 * j) = v * r * w; }
        }
    }
}

extern "C" void kernel_launch(void* const* d_in, const int* in_sizes, int n_in, void* d_out, int out_size, void* d_ws, size_t ws_size, hipStream_t stream) {
    static int grid = 0;
    if (grid == 0) {
        if (n_in != 18 || (size_t)out_size != O_END || ws_size < WS_END) { fprintf(stderr, "kernel_launch: unexpected shapes (n_in %d out %d ws %zu need %zu)\n", n_in, out_size, ws_size, (size_t)WS_END); grid = -1; return; }
        int dev = 0, cus = 0, per_cu = 0;
        if (hipGetDevice(&dev) != hipSuccess || hipDeviceGetAttribute(&cus, hipDeviceAttributeMultiprocessorCount, dev) != hipSuccess) { grid = -1; return; }
        if (hipFuncSetAttribute((const void*)fwd, hipFuncAttributeMaxDynamicSharedMemorySize, LDS_BYTES) != hipSuccess) { fprintf(stderr, "kernel_launch: hipFuncSetAttribute failed\n"); grid = -1; return; }
        if (hipOccupancyMaxActiveBlocksPerMultiprocessor(&per_cu, (const void*)fwd, NTHR, LDS_BYTES) != hipSuccess || per_cu < 1) { fprintf(stderr, "kernel_launch: occupancy query says %d\n", per_cu); }
        (void)hipGetLastError();
        grid = cus;
    }
    if (grid < 0) return;
    (void)hipMemsetAsync((char*)d_ws + WS_CTL, 0, CTL_ZERO_BYTES, stream);
    Args a{};
    a.x_prompt = (const float*)d_in[0]; a.x_sample = (const float*)d_in[1]; a.state_delta = (const float*)d_in[2]; a.state_conv = (const float*)d_in[3]; a.state_pool = (const float*)d_in[4];
    a.norm_mix = (const float*)d_in[5]; a.w_in = (const float*)d_in[6]; a.conv_w = (const float*)d_in[7]; a.a_log = (const float*)d_in[8]; a.dt_bias = (const float*)d_in[9];
    a.dn_norm = (const float*)d_in[10]; a.w_pool = (const float*)d_in[11]; a.pool_scale = (const float*)d_in[12]; a.w_out = (const float*)d_in[13]; a.norm_ffn = (const float*)d_in[14];
    a.w_gate_up = (const float*)d_in[15]; a.w_down = (const float*)d_in[16]; a.norm_final = (const float*)d_in[17];
    a.out = (float*)d_out; a.ws = (unsigned char*)d_ws;
#if MK_N_LAUNCHES == 1
    a.ph_lo = 0; a.ph_hi = N_PHASES;
    hipLaunchKernelGGL(fwd, dim3(grid), dim3(NTHR), LDS_BYTES, stream, a);
#else
    for (int p = 0; p < N_PHASES; ++p) { a.ph_lo = p; a.ph_hi = p + 1; hipLaunchKernelGGL(fwd, dim3(grid), dim3(NTHR), LDS_BYTES, stream, a); }
#endif
}
```

```cpp
#include <hip/hip_runtime.h>
#include <cstdio>
#include <cstdint>

#ifndef MK_N_LAUNCHES
#define MK_N_LAUNCHES 1
#endif

namespace pg8 {
#define PG8_LAS __attribute__((address_space(3)))
typedef unsigned short bf16_t;
typedef short bf16x8 __attribute__((ext_vector_type(8)));
typedef float f32x4 __attribute__((ext_vector_type(4)));
typedef unsigned u32x4 __attribute__((ext_vector_type(4)));
typedef unsigned u32x2 __attribute__((ext_vector_type(2)));
constexpr int BM = 256, BK = 64, HALF = 128, HTB = HALF * BK * 2, STAGE_BYTES = 8 * HTB, NXCD = 8, WGM = 8;

__host__ __device__ __forceinline__ int lds_byte(int r, int c) { const int st = (r >> 4) * 2 + (c >> 5), rr = r & 15, cc = c & 31, ob = rr * 64 + cc * 2; return st * 1024 + (ob ^ (((ob >> 9) & 1) << 5)); }
__host__ __device__ __forceinline__ void stage_rc(int b, int& R, int& C) { const int st = b / 1024, sb = b % 1024, swz = sb ^ (((sb >> 9) & 1) << 5); R = (st >> 1) * 16 + swz / 64; C = (st & 1) * 32 + (swz % 64) / 2; }
__host__ __device__ __forceinline__ int perm32(int rho) { const int n = rho >> 4, i = rho & 15; return 8 * (i >> 2) + 4 * n + (i & 3); }

struct Unit { int pm, pn; };
struct Gemm { const bf16_t* A; const bf16_t* Bt; int M, N, K, lda, ldb; long a_pn_bytes; };

struct StaticOrder {
    int nM, nN, nwg, G, c;
    __host__ __device__ void init(int M, int N, int G_, int c_) { nM = M / BM; nN = N / BM; nwg = nM * nN; G = G_; c = c_; }
    __host__ __device__ bool next(int i, Unit& u) const {
        const long L = (long)i * G + c; if (L >= nwg) return false;
        int wgid = (int)L; { const int q = nwg / NXCD, r = nwg % NXCD, xcd = wgid % NXCD, off = wgid / NXCD; wgid = (xcd < r ? xcd * (q + 1) : r * (q + 1) + (xcd - r) * q) + off; }
        const int nig = WGM * nN, gid = wgid / nig, fm = gid * WGM, gsz = (nM - fm) < WGM ? (nM - fm) : WGM;
        u.pm = fm + ((wgid % nig) % gsz); u.pn = (wgid % nig) / gsz; return true;
    }
    __device__ __forceinline__ void a_ready(const Unit&) const {}
    __device__ __forceinline__ void done(const Unit&) const {}
};

__device__ __forceinline__ unsigned cvt_pk_bf16(float lo, float hi) { unsigned r; asm volatile("v_cvt_pk_bf16_f32 %0, %1, %2" : "=v"(r) : "v"(lo), "v"(hi)); return r; }

template <class Epi, class Sched, bool ALIGN_EPI = false, bool SP2 = false>
__device__ __forceinline__ void gemm_phase(PG8_LAS unsigned char* lds, const Gemm g, const Sched& S, const Epi& E) {
    int tid_ = threadIdx.x; asm volatile("" : "+v"(tid_));
    const int tid = tid_, wid = __builtin_amdgcn_readfirstlane(tid >> 6), lane = tid & 63, wr = wid >> 2, wc = wid & 3, fr = lane & 15, fq = lane >> 4;
    const int K = g.K, nt = K / BK;
    unsigned voffA[2], voffB[2];
#pragma unroll
    for (int i = 0; i < 2; ++i) { int R, C; stage_rc(tid * 16 + i * 8192, R, C); const int Rb = Epi::PERM ? ((R & ~31) + perm32(R & 31)) : R;
        voffA[i] = (unsigned)(R * g.lda + C) * 2u; voffB[i] = (unsigned)(Rb * g.ldb + C) * 2u; }
    const size_t kstep = (size_t)(BK * 2);
    const size_t hstepA = (size_t)HALF * g.lda * 2, hstepB = (size_t)HALF * g.ldb * 2;
    const size_t tstepA = 2 * hstepA, tstepB = 2 * hstepB;
    const unsigned ldsw = (unsigned)wid * 1024u;
    const int aoff = lds_byte(wr * 64 + fr, fq * 8), boff = lds_byte(wc * 32 + fr, fq * 8);
#define PG8_SA(b, h) (((b) * 2 + (h)) * HTB)
#define PG8_SB(b, h) ((4 + (b) * 2 + (h)) * HTB)
#define PG8_STAGE(bufoff, gbase, voff) do { _Pragma("unroll") for (int _i = 0; _i < 2; ++_i) { unsigned _vo = (voff)[_i]; asm volatile("" : "+v"(_vo));   \
        __builtin_amdgcn_global_load_lds((const unsigned*)((const char*)(gbase) + _vo), (PG8_LAS unsigned*)(lds + (bufoff) + ldsw + _i * 8192), 16, 0, 0); } } while (0)
#define PG8_LDA(dst, b, h) do { _Pragma("unroll") for (int m = 0; m < 4; ++m) _Pragma("unroll") for (int k = 0; k < 2; ++k) dst[m][k] = *(const PG8_LAS bf16x8*)(lds + PG8_SA(b, h) + aoff + m * 2048 + k * 1024); } while (0)
#define PG8_LDB(dst, b, h) do { _Pragma("unroll") for (int n = 0; n < 2; ++n) _Pragma("unroll") for (int k = 0; k < 2; ++k) dst[n][k] = *(const PG8_LAS bf16x8*)(lds + PG8_SB(b, h) + boff + n * 2048 + k * 1024); } while (0)
#define PG8_MMA(ai, bj, At, Bt) do { __builtin_amdgcn_s_setprio(1); _Pragma("unroll") for (int m = 0; m < 4; ++m) _Pragma("unroll") for (int n = 0; n < 2; ++n) _Pragma("unroll") for (int k = 0; k < 2; ++k) \
        acc[ai][bj][m][n] = __builtin_amdgcn_mfma_f32_16x16x32_bf16(Bt[n][k], At[m][k], acc[ai][bj][m][n], 0, 0, 0); __builtin_amdgcn_s_setprio(0); } while (0)
#define PG8_WAIT_V(n) asm volatile("s_waitcnt vmcnt(" #n ")" ::: "memory")
#define PG8_WAIT_L(n) asm volatile("s_waitcnt lgkmcnt(" #n ")" ::: "memory")
#define PG8_BAR __builtin_amdgcn_s_barrier()
#define PG8_SCHED __builtin_amdgcn_sched_barrier(0)
    Unit cur, nxt; int ui = 0;
    if (!S.next(0, cur)) return;
    f32x4 acc[2][2][4][2];
#pragma unroll
    for (int a = 0; a < 2; ++a)
#pragma unroll
        for (int b = 0; b < 2; ++b)
#pragma unroll
            for (int m = 0; m < 4; ++m)
#pragma unroll
                for (int n = 0; n < 2; ++n) acc[a][b][m][n] = (f32x4){0.f, 0.f, 0.f, 0.f};
    bf16x8 At[4][2], B0[2][2], B1[2][2];
    const char* cA = (const char*)g.A + (size_t)cur.pm * tstepA + (size_t)cur.pn * g.a_pn_bytes; const char* cB = (const char*)g.Bt + (size_t)cur.pn * tstepB;
    S.a_ready(cur);
    if constexpr (SP2) {
        PG8_STAGE(PG8_SB(0, 0), cB, voffB); PG8_STAGE(PG8_SB(0, 1), cB + hstepB, voffB); PG8_STAGE(PG8_SA(0, 0), cA, voffA); PG8_STAGE(PG8_SA(0, 1), cA + hstepA, voffA);
        if (wr == 1) PG8_BAR;
        PG8_WAIT_V(2); PG8_BAR;
        PG8_STAGE(PG8_SB(1, 0), cB + kstep, voffB); PG8_STAGE(PG8_SA(1, 0), cA + kstep, voffA); PG8_STAGE(PG8_SB(1, 1), cB + hstepB + kstep, voffB);
        PG8_WAIT_V(6); PG8_BAR;
    } else {
        PG8_STAGE(PG8_SB(0, 0), cB, voffB); PG8_STAGE(PG8_SA(0, 0), cA, voffA); PG8_STAGE(PG8_SB(0, 1), cB + hstepB, voffB); PG8_STAGE(PG8_SA(0, 1), cA + hstepA, voffA);
        if (wr == 1) PG8_BAR;
        PG8_WAIT_V(4); PG8_BAR;
        PG8_STAGE(PG8_SB(1, 0), cB + kstep, voffB); PG8_STAGE(PG8_SA(1, 0), cA + kstep, voffA); PG8_STAGE(PG8_SB(1, 1), cB + hstepB + kstep, voffB);
        PG8_WAIT_V(6); PG8_BAR;
    }
    for (;;) {
        const bool has_next = S.next(ui + 1, nxt);
        const char* nA = has_next ? (const char*)g.A + (size_t)nxt.pm * tstepA + (size_t)nxt.pn * g.a_pn_bytes : cA; const char* nB = has_next ? (const char*)g.Bt + (size_t)nxt.pn * tstepB : cB;
        for (int t = 0; t < nt; t += 2) {
            const bool last = (t == nt - 2);
            const char* a1 = cA + (size_t)(t + 1) * kstep;
            const char* a2 = last ? nA : cA + (size_t)(t + 2) * kstep; const char* b2 = last ? nB : cB + (size_t)(t + 2) * kstep;
            const char* a3 = a2 + kstep; const char* b3 = b2 + kstep;
            if (last && has_next) S.a_ready(nxt);
            if constexpr (SP2) {
            PG8_LDB(B0, 0, 0); PG8_LDB(B1, 0, 1); PG8_SCHED; PG8_LDA(At, 0, 0); PG8_STAGE(PG8_SA(1, 1), a1 + hstepA, voffA);
            PG8_WAIT_V(8); PG8_WAIT_L(0); PG8_BAR; PG8_MMA(0, 0, At, B0); PG8_MMA(0, 1, At, B1); PG8_BAR; PG8_SCHED;
            PG8_LDA(At, 0, 1); PG8_STAGE(PG8_SB(0, 0), b2, voffB); PG8_STAGE(PG8_SB(0, 1), b2 + hstepB, voffB); PG8_STAGE(PG8_SA(0, 0), a2, voffA);
            PG8_WAIT_V(8); PG8_WAIT_L(0); PG8_BAR; PG8_MMA(1, 0, At, B0); PG8_MMA(1, 1, At, B1); PG8_BAR; PG8_SCHED;
            PG8_LDB(B0, 1, 0); PG8_LDB(B1, 1, 1); PG8_SCHED; PG8_LDA(At, 1, 0); PG8_STAGE(PG8_SA(0, 1), a2 + hstepA, voffA);
            PG8_WAIT_V(8); PG8_WAIT_L(0); PG8_BAR; PG8_MMA(0, 0, At, B0); PG8_MMA(0, 1, At, B1); PG8_BAR; PG8_SCHED;
            PG8_LDA(At, 1, 1); PG8_STAGE(PG8_SB(1, 0), b3, voffB); PG8_STAGE(PG8_SB(1, 1), b3 + hstepB, voffB); PG8_STAGE(PG8_SA(1, 0), a3, voffA);
            PG8_WAIT_V(8); PG8_WAIT_L(0); PG8_BAR; PG8_MMA(1, 0, At, B0); PG8_MMA(1, 1, At, B1); PG8_BAR; PG8_SCHED;
            } else {
            PG8_LDB(B0, 0, 0); PG8_SCHED; PG8_LDA(At, 0, 0); PG8_STAGE(PG8_SA(1, 1), a1 + hstepA, voffA);
            PG8_WAIT_L(8); PG8_BAR; PG8_WAIT_L(0); PG8_MMA(0, 0, At, B0); PG8_BAR; PG8_SCHED;
            PG8_LDB(B1, 0, 1); PG8_STAGE(PG8_SB(0, 0), b2, voffB);
            PG8_BAR; PG8_WAIT_L(0); PG8_MMA(0, 1, At, B1); PG8_BAR;
            PG8_LDA(At, 0, 1); PG8_STAGE(PG8_SA(0, 0), a2, voffA);
            PG8_BAR; PG8_WAIT_L(0); PG8_MMA(1, 0, At, B0); PG8_BAR; PG8_SCHED;
            PG8_STAGE(PG8_SB(0, 1), b2 + hstepB, voffB);
            PG8_WAIT_V(6); PG8_BAR; PG8_MMA(1, 1, At, B1); PG8_BAR;
            PG8_LDB(B0, 1, 0); PG8_SCHED; PG8_LDA(At, 1, 0); PG8_STAGE(PG8_SA(0, 1), a2 + hstepA, voffA);
            PG8_WAIT_L(8); PG8_BAR; PG8_WAIT_L(0); PG8_MMA(0, 0, At, B0); PG8_BAR; PG8_SCHED;
            PG8_LDB(B1, 1, 1); PG8_STAGE(PG8_SB(1, 0), b3, voffB);
            PG8_BAR; PG8_WAIT_L(0); PG8_MMA(0, 1, At, B1); PG8_BAR;
            PG8_LDA(At, 1, 1); PG8_STAGE(PG8_SA(1, 0), a3, voffA);
            PG8_BAR; PG8_WAIT_L(0); PG8_MMA(1, 0, At, B0); PG8_BAR; PG8_SCHED;
            PG8_STAGE(PG8_SB(1, 1), b3 + hstepB, voffB);
            PG8_WAIT_V(6); PG8_BAR; PG8_MMA(1, 1, At, B1); PG8_BAR;
            }
        }
        if constexpr (ALIGN_EPI) { if (wr == 0) PG8_BAR; }
        E(acc, cur, wr, wc, fr, fq); S.done(cur);
        if (!has_next) break;
#pragma unroll
        for (int a = 0; a < 2; ++a)
#pragma unroll
            for (int b = 0; b < 2; ++b)
#pragma unroll
                for (int m = 0; m < 4; ++m)
#pragma unroll
                    for (int n = 0; n < 2; ++n) acc[a][b][m][n] = (f32x4){0.f, 0.f, 0.f, 0.f};
        cur = nxt; cA = nA; cB = nB; ++ui;
        if constexpr (ALIGN_EPI) { if (wr == 1) PG8_BAR; }
    }
    PG8_WAIT_V(0);
    if constexpr (!ALIGN_EPI) { if (wr == 0) PG8_BAR; }
    PG8_BAR;
#undef PG8_SA
#undef PG8_SB
#undef PG8_STAGE
#undef PG8_LDA
#undef PG8_LDB
#undef PG8_MMA
#undef PG8_WAIT_V
#undef PG8_WAIT_L
#undef PG8_BAR
#undef PG8_SCHED
}
}

constexpr int NWAVES = 8, NTHR = 512;
constexpr int DM = 2048, NB = 4, SEQ = 2048, DEPTH = 4, DECB = 128;
constexpr int DNW = 1024, NH = 8, HD = 128, POOLW = 1024, DFF = 5632, INC = 5136;
constexpr int MP = NB * SEQ;
constexpr int MR = MP + DECB;
constexpr int MPAD = 8448;
constexpr int NIN = 5376;
constexpr int PROJ_LD = 5120;
constexpr float EPS = 1e-6f;

constexpr size_t O_YP = 0, O_YS = 16777216, O_DP = 17039360, O_CP = 19136512, O_PP = 19283968, O_DS = 19529728, O_CS = 86638592, O_PS = 91357184, O_END = 99221504;

constexpr size_t MiB = 1u << 20;
constexpr size_t WS_CTL = 0, CTL_ZERO_BYTES = 1 * MiB;
constexpr size_t SZ_WIN = (size_t)NIN * DM * 2, SZ_WOUT = (size_t)DM * DM * 2, SZ_WGU = (size_t)2 * DFF * DM * 2, SZ_WD = (size_t)DM * DFF * 2, SZ_WP = (size_t)4 * 256 * 256 * 2;
constexpr size_t WS_WIN = 2 * MiB;
constexpr size_t WS_WOUT = WS_WIN + DEPTH * SZ_WIN;
constexpr size_t WS_WGU = WS_WOUT + DEPTH * SZ_WOUT;
constexpr size_t WS_WD = WS_WGU + DEPTH * SZ_WGU;
constexpr size_t WS_WP = WS_WD + DEPTH * SZ_WD;
constexpr size_t WS_H = WS_WP + DEPTH * SZ_WP;
constexpr size_t WS_HB = WS_H + (size_t)MPAD * DM * 4;
constexpr size_t WS_PROJ = WS_HB + (size_t)MPAD * DM * 2;
constexpr size_t WS_BA = WS_PROJ + (size_t)MPAD * PROJ_LD * 2;
constexpr size_t WS_CAT = WS_BA + (size_t)MPAD * 16 * 4;
constexpr size_t WS_DB = WS_CAT + (size_t)MPAD * DM * 2;
constexpr size_t WS_ACT = WS_DB + (size_t)MPAD * POOLW * 2;
constexpr size_t WS_SSQ = WS_ACT + (size_t)MPAD * DFF * 2;
constexpr int NUNIT = NB * NH * (SEQ / 64);
constexpr size_t WS_DW = WS_SSQ + (size_t)MPAD * 32 * 4;
constexpr size_t WS_DQG = WS_DW + (size_t)NUNIT * 64 * 128 * 2;
constexpr size_t WS_DQK = WS_DQG + (size_t)NUNIT * 64 * 128 * 2;
constexpr size_t WS_DKD = WS_DQK + (size_t)NUNIT * 64 * 64 * 2;
constexpr size_t WS_DU = WS_DKD + (size_t)NUNIT * 128 * 64 * 2;
constexpr size_t WS_EGL = WS_DU + (size_t)NUNIT * 128 * 64 * 4;
constexpr size_t WS_OB = WS_EGL + (size_t)NUNIT * 4;
constexpr size_t WS_OSSQ = WS_OB + (size_t)MP * DNW * 4;
constexpr size_t WS_DSSQ = WS_OSSQ + (size_t)MP * 64 * 4;
constexpr size_t WS_END = WS_DSSQ + (size_t)DECB * 64 * 4;
constexpr int CW_BAR = 4096, CW_SCAN = 8192;

constexpr int LDS_BYTES = 147456;
constexpr int MISC_OFF = 131072 + 8192 + 4096;

#define LAS __attribute__((address_space(3)))
typedef unsigned short bf16;
typedef unsigned v4u __attribute__((ext_vector_type(4)));
typedef unsigned v2u __attribute__((ext_vector_type(2)));
typedef float f32x4 __attribute__((ext_vector_type(4)));
#define LDS_WAIT() asm volatile("s_waitcnt lgkmcnt(0)" ::: "memory")
#define VM_WAIT() asm volatile("s_waitcnt vmcnt(0)" ::: "memory")
__device__ __forceinline__ unsigned f2bf(float f) { unsigned u = __builtin_bit_cast(unsigned, f); return (u + 0x7fffu + ((u >> 16) & 1u)) >> 16; }
__device__ __forceinline__ unsigned pk2(float lo, float hi) { return f2bf(lo) | (f2bf(hi) << 16); }
__device__ __forceinline__ float bf2f(bf16 b) { return __builtin_bit_cast(float, ((unsigned)b) << 16); }
__device__ __forceinline__ float silu_f(float x) { return x * __builtin_amdgcn_rcpf(1.0f + __expf(-x)); }
__device__ __forceinline__ float sigmoid_f(float x) { return __builtin_amdgcn_rcpf(1.0f + __expf(-x)); }
__device__ __forceinline__ float softplus_f(float x) { const float e = __expf(x); const float sm = e * (1.0f - e * (0.5f - e * 0.33333333f)); const float lg = __logf(1.0f + e); return x > 20.f ? x : (e < 0.01f ? sm : lg); }
__device__ __forceinline__ float rsqrt_f(float x) { return __builtin_amdgcn_rsqf(x); }
__device__ __forceinline__ float dpp_f(float v, const int ctrl_sel) { return v; }
#define DPP_ADD(v, ctrl, rmask) do { const int t_ = __builtin_amdgcn_update_dpp(0, __builtin_bit_cast(int, (v)), (ctrl), (rmask), 0xF, false); (v) += __builtin_bit_cast(float, t_); } while (0)
__device__ __forceinline__ float row_sum16(float v) {
    DPP_ADD(v, 0xB1, 0xF);
    DPP_ADD(v, 0x4E, 0xF);
    DPP_ADD(v, 0x141, 0xF);
    DPP_ADD(v, 0x140, 0xF);
    return v;
}
__device__ __forceinline__ float wave_sum(float v) {
    v = row_sum16(v);
    DPP_ADD(v, 0x142, 0xA);
    DPP_ADD(v, 0x143, 0xC);
    return __builtin_bit_cast(float, __builtin_amdgcn_readlane(__builtin_bit_cast(int, v), 63));
}

#define XB_TMO      128
#define XB_XCNT(j)  (256  + 64 * (j))
#define XB_XSUB(j)  (1280 + 64 * (j))
#define XB_XGEN(j)  (2304 + 64 * (j))
#define XB_TOP      3328
#define XB_TOPGEN   3392
#define XCD_BAR_WORDS 3456
#define XB_SPIN_CAP (1u << 22)
__device__ __forceinline__ unsigned xb_ld(unsigned* p)              { return __hip_atomic_load(p, __ATOMIC_RELAXED, __HIP_MEMORY_SCOPE_AGENT); }
__device__ __forceinline__ unsigned xb_add(unsigned* p, unsigned v) { return __hip_atomic_fetch_add(p, v, __ATOMIC_RELAXED, __HIP_MEMORY_SCOPE_AGENT); }
__device__ __forceinline__ unsigned xb_xcc_id() { return (unsigned)__builtin_amdgcn_s_getreg((3 << 11) | 20) & 0xFu; }
#define XB_SPIN(cond, bar) do { unsigned _sp = 0; while (cond) { __builtin_amdgcn_s_sleep(1); \
    if ((++_sp & 255u) == 0u) { if (xb_ld(&(bar)[XB_TMO])) break; if (_sp > XB_SPIN_CAP) { atomicAdd(&(bar)[XB_TMO], 1u); break; } } } } while (0)
struct XcdBarrier { unsigned* bar; unsigned x; volatile LAS unsigned* st; };
__device__ __forceinline__ XcdBarrier xcd_barrier_post(unsigned* bar, volatile LAS unsigned* st) {
    XcdBarrier b; b.bar = bar; b.x = xb_xcc_id(); b.st = st;
    if (threadIdx.x == 0) (void)xb_add(&bar[XB_XCNT(b.x)], 1u);
    return b;
}
__device__ __forceinline__ void xcd_barrier_complete(unsigned* bar, unsigned x, unsigned& nloc, unsigned& nx) {
    const unsigned G = gridDim.x * gridDim.y * gridDim.z;
    unsigned sum, cnt, mine, sp = 0u;
    for (;;) {
        sum = 0u; cnt = 0u; mine = 0u;
#pragma unroll
        for (unsigned j = 0; j < 16; ++j) { const unsigned c = xb_ld(&bar[XB_XCNT(j)]); sum += c; cnt += (c > 0u) ? 1u : 0u; mine = (j == x) ? c : mine; }
        if (sum == G) break;
        __builtin_amdgcn_s_sleep(1);
        if ((++sp & 255u) == 0u) { if (xb_ld(&bar[XB_TMO])) break; if (sp > XB_SPIN_CAP) { atomicAdd(&bar[XB_TMO], 1u); break; } }
    }
    nloc = mine > 0u ? mine : 1u; nx = cnt > 0u ? cnt : 1u;
}
__device__ __forceinline__ void xcd_barrier(const XcdBarrier& b) {
    asm volatile("s_waitcnt vmcnt(0)" ::: "memory");
    __syncthreads();
    if (threadIdx.x == 0) {
        unsigned* bar = b.bar;
        __builtin_amdgcn_s_waitcnt(0);
        unsigned nloc = b.st[0], nx = b.st[1];
        if (nloc == 0u) { xcd_barrier_complete(bar, b.x, nloc, nx); b.st[0] = nloc; b.st[1] = nx; }
        const unsigned old = xb_add(&bar[XB_XSUB(b.x)], 1u);
        const unsigned gen = old / nloc;
        if (old + 1u == (gen + 1u) * nloc) {
            __builtin_amdgcn_fence(__ATOMIC_RELEASE, "agent");
            asm volatile("s_waitcnt vmcnt(0)" ::: "memory");
            const unsigned og = xb_add(&bar[XB_TOP], 1u);
            const unsigned tg = og / nx;
            if (og + 1u == (tg + 1u) * nx) xb_add(&bar[XB_TOPGEN], 1u);
            else XB_SPIN(xb_ld(&bar[XB_TOPGEN]) == tg, bar);
            __builtin_amdgcn_fence(__ATOMIC_ACQUIRE, "agent");
            xb_add(&bar[XB_XGEN(b.x)], 1u);
            asm volatile("s_waitcnt vmcnt(0)" ::: "memory");
        } else {
            XB_SPIN(xb_ld(&bar[XB_XGEN(b.x)]) == gen, bar);
            __builtin_amdgcn_fence(__ATOMIC_ACQUIRE, "agent");
            asm volatile("s_waitcnt vmcnt(0)" ::: "memory");
        }
    }
    __syncthreads();
}

struct Args {
    const float *x_prompt, *x_sample, *state_delta, *state_conv, *state_pool, *norm_mix, *w_in, *conv_w, *a_log, *dt_bias, *dn_norm, *w_pool, *pool_scale, *w_out, *norm_ffn, *w_gate_up, *w_down, *norm_final;
    float* out; unsigned char* ws; int ph_lo, ph_hi;
};

__device__ __forceinline__ void tr_item(const float* W, int ldw, const float* kscale, bf16* WT, int K, int k0, int d0, int sc, LAS float* scr, int lane) {
    float tv[32];
#pragma unroll
    for (int i = 0; i < 32; ++i) { const int kk = 2 * i + (lane >> 5); tv[i] = sc >= 0 ? W[(size_t)(k0 + kk) * ldw + sc] : 0.f; }
#pragma unroll
    for (int i = 0; i < 32; ++i) { const int kk = 2 * i + (lane >> 5); float v = tv[i]; if (kscale) v *= kscale[k0 + kk]; scr[kk * 33 + (lane & 31)] = v; }
    LDS_WAIT(); asm volatile("" ::: "memory");
    const int c = lane & 7;
#pragma unroll
    for (int j = 0; j < 4; ++j) { const int n = (lane >> 3) + 8 * j; const LAS float* s = scr + (8 * c) * 33 + n;
        v4u o; o.x = pk2(s[0 * 33], s[1 * 33]); o.y = pk2(s[2 * 33], s[3 * 33]); o.z = pk2(s[4 * 33], s[5 * 33]); o.w = pk2(s[6 * 33], s[7 * 33]);
        *(v4u*)(WT + (size_t)(d0 + n) * K + k0 + 8 * c) = o; }
    LDS_WAIT(); asm volatile("" ::: "memory");
}
__device__ __forceinline__ int srccol_in(int d) { return d < 4096 ? d : (d < 5120 ? d + 16 : (d < 5136 ? d - 1024 : -1)); }
__device__ __forceinline__ int srccol_gu(int d) { const int j = d >> 8, w = d & 255; return w < 128 ? 128 * j + w : DFF + 128 * j + (w - 128); }
constexpr int I_IN = 32 * (NIN / 32), I_OUT = 32 * 64, I_GU = 32 * (2 * DFF / 32), I_D = (DFF / 64) * 64, I_P = 4 * 4 * 8, I_L = I_IN + I_OUT + I_GU + I_D + I_P;
constexpr int CV_PER_WG = 24;
constexpr int CV_A = 96 * CV_PER_WG, CV_B = 128 * CV_PER_WG;
constexpr int CV_PW_C = 16, CV_PW_D = 56, CV_C = 192 * CV_PW_C, CV_D = 192 * CV_PW_D, CV_END = CV_A + CV_B + CV_C + CV_D;
struct CvP { const float *w_in, *norm_mix, *w_out, *w_gate_up, *norm_ffn, *w_down, *w_pool; bf16 *WinT, *WoutT, *WguT, *WdT, *WpT; };
__device__ __forceinline__ void convert_item(const CvP& C, int l, int r, LAS float* scr, int lane) {
    if (r < I_IN) { const int nblk = NIN / 32, kb = r / nblk, nb = r % nblk; tr_item(C.w_in + (size_t)l * DM * INC, INC, C.norm_mix + l * DM, C.WinT + (size_t)l * NIN * DM, DM, 64 * kb, 32 * nb, srccol_in(32 * nb + (lane & 31)), scr, lane); return; } r -= I_IN;
    if (r < I_OUT) { const int kb = r / 64, nb = r % 64; tr_item(C.w_out + (size_t)l * DM * DM, DM, nullptr, C.WoutT + (size_t)l * DM * DM, DM, 64 * kb, 32 * nb, 32 * nb + (lane & 31), scr, lane); return; } r -= I_OUT;
    if (r < I_GU) { const int nblk = 2 * DFF / 32, kb = r / nblk, nb = r % nblk; tr_item(C.w_gate_up + (size_t)l * DM * 2 * DFF, 2 * DFF, C.norm_ffn + l * DM, C.WguT + (size_t)l * 2 * DFF * DM, DM, 64 * kb, 32 * nb, srccol_gu(32 * nb + (lane & 31)), scr, lane); return; } r -= I_GU;
    if (r < I_D) { const int kb = r / 64, nb = r % 64; tr_item(C.w_down + (size_t)l * DFF * DM, DM, nullptr, C.WdT + (size_t)l * DM * DFF, DFF, 64 * kb, 32 * nb, 32 * nb + (lane & 31), scr, lane); return; } r -= I_D;
    { const int g = r / 32, rr = r % 32, kb = rr / 8, nb = rr % 8; tr_item(C.w_pool + (size_t)(l * 4 + g) * 65536, 256, nullptr, C.WpT + (size_t)(l * 4 + g) * 65536, 256, 64 * kb, 32 * nb, 32 * nb + (lane & 31), scr, lane); }
}
__device__ __forceinline__ void convert_tail(const CvP& C, LAS unsigned char* lds, int l_next, int base, int si, int ns, int quota, int per_wg = CV_PER_WG) {
    if (si < 0) return;
    int tl = threadIdx.x; asm volatile("" : "+v"(tl)); const int lane = tl & 63, wave = __builtin_amdgcn_readfirstlane(tl >> 6);
    LAS float* scr = (LAS float*)(lds + wave * 16384);
    for (int j = wave; j < per_wg; j += NWAVES) { const int r = j * ns + si; if (r < quota) convert_item(C, l_next, base + r, scr, lane); }
    __syncthreads();
}

__device__ __forceinline__ float row_scale1(const float* ssq, int row, int fq) {
    const f32x4* p = (const f32x4*)(ssq + (size_t)row * 32 + 8 * fq); const f32x4 a = p[0], b = p[1];
    float s = ((a[0] + a[1]) + (a[2] + a[3])) + ((b[0] + b[1]) + (b[2] + b[3])); s += __shfl_xor(s, 16); s += __shfl_xor(s, 32);
    return rsqrt_f(s * (1.0f / DM) + EPS);
}
#define EPI_FENCE() asm volatile("" ::: "memory")
struct EpiIn {
    static constexpr bool PERM = true;
    bf16* proj; float* ba; const float* ssq;
    __device__ __forceinline__ void operator()(const f32x4 (&acc)[2][2][4][2], const pg8::Unit& u, int wr, int wc, int fr_, int fq_) const {
        int fr = fr_, fq = fq_; asm volatile("" : "+v"(fr), "+v"(fq));
        const int row0 = u.pm * 256 + wr * 64 + fr;
        if (u.pn < 20) {
            const int col0 = u.pn * 256 + wc * 32 + 8 * fq;
#pragma unroll
            for (int ai = 0; ai < 2; ++ai)
#pragma unroll
                for (int m = 0; m < 4; ++m) { const int row = row0 + ai * 128 + m * 16; bf16* rowp = proj + (size_t)row * PROJ_LD + col0; const float r = row_scale1(ssq, row, fq);
#pragma unroll
                    for (int bj = 0; bj < 2; ++bj) { const f32x4 v0 = acc[ai][bj][m][0] * r, v1 = acc[ai][bj][m][1] * r;
                        v4u w; w.x = pg8::cvt_pk_bf16(v0[0], v0[1]); w.y = pg8::cvt_pk_bf16(v0[2], v0[3]); w.z = pg8::cvt_pk_bf16(v1[0], v1[1]); w.w = pg8::cvt_pk_bf16(v1[2], v1[3]);
                        *(v4u*)(rowp + bj * 128) = w; }
                    EPI_FENCE(); }
        } else {
#pragma unroll
            for (int ai = 0; ai < 2; ++ai)
#pragma unroll
                for (int m = 0; m < 4; ++m) { const int row = row0 + ai * 128 + m * 16; const float r = row_scale1(ssq, row, fq);
                    if (wc == 0 && fq < 2) { float* rowp = ba + (size_t)row * 16 + 8 * fq; *(f32x4*)(rowp) = acc[ai][0][m][0] * r; *(f32x4*)(rowp + 4) = acc[ai][0][m][1] * r; }
                    EPI_FENCE(); }
        }
    }
};
struct EpiRes {
    static constexpr bool PERM = true;
    bf16* hb; float* ssq;
    __device__ __forceinline__ void operator()(const f32x4 (&acc)[2][2][4][2], const pg8::Unit& u, int wr, int wc, int fr_, int fq_) const {
        int fr = fr_, fq = fq_; asm volatile("" : "+v"(fr), "+v"(fq));
        const int row0 = u.pm * 256 + wr * 64 + fr, col0 = u.pn * 256 + wc * 32 + 8 * fq;
#pragma unroll
        for (int ai = 0; ai < 2; ++ai)
#pragma unroll
            for (int m = 0; m < 4; ++m) { const int row = row0 + ai * 128 + m * 16; bf16* bp = hb + (size_t)row * DM + col0; float sq = 0.f;
#pragma unroll
                for (int bj = 0; bj < 2; ++bj) { const v4u o = *(const v4u*)(bp + bj * 128);
                    f32x4 v0 = acc[ai][bj][m][0], v1 = acc[ai][bj][m][1];
                    v0[0] += __builtin_bit_cast(float, o.x << 16); v0[1] += __builtin_bit_cast(float, o.x & 0xffff0000u); v0[2] += __builtin_bit_cast(float, o.y << 16); v0[3] += __builtin_bit_cast(float, o.y & 0xffff0000u);
                    v1[0] += __builtin_bit_cast(float, o.z << 16); v1[1] += __builtin_bit_cast(float, o.z & 0xffff0000u); v1[2] += __builtin_bit_cast(float, o.w << 16); v1[3] += __builtin_bit_cast(float, o.w & 0xffff0000u);
                    sq += ((v0[0] * v0[0] + v0[1] * v0[1]) + (v0[2] * v0[2] + v0[3] * v0[3])) + ((v1[0] * v1[0] + v1[1] * v1[1]) + (v1[2] * v1[2] + v1[3] * v1[3]));
                    v4u w; w.x = pg8::cvt_pk_bf16(v0[0], v0[1]); w.y = pg8::cvt_pk_bf16(v0[2], v0[3]); w.z = pg8::cvt_pk_bf16(v1[0], v1[1]); w.w = pg8::cvt_pk_bf16(v1[2], v1[3]);
                    *(v4u*)(bp + bj * 128) = w; }
                sq += __shfl_xor(sq, 16); sq += __shfl_xor(sq, 32);
                if (fq == 0) ssq[(size_t)row * 32 + u.pn * 4 + wc] = sq;
                EPI_FENCE(); }
    }
};
struct EpiSwiGLU {
    static constexpr bool PERM = true;
    bf16* act; const float* ssq;
    __device__ __forceinline__ void operator()(const f32x4 (&acc)[2][2][4][2], const pg8::Unit& u, int wr, int wc, int fr_, int fq_) const {
        int fr = fr_, fq = fq_; asm volatile("" : "+v"(fr), "+v"(fq));
        const int row0 = u.pm * 256 + wr * 64 + fr, col0 = u.pn * 128 + wc * 32 + 8 * fq;
#pragma unroll
        for (int ai = 0; ai < 2; ++ai)
#pragma unroll
            for (int m = 0; m < 4; ++m) { const int row = row0 + ai * 128 + m * 16; const float r = row_scale1(ssq, row, fq); v4u w;
#pragma unroll
                for (int n = 0; n < 2; ++n) { const f32x4 gt = acc[ai][0][m][n] * r, up = acc[ai][1][m][n] * r;
                    const float o0 = silu_f(gt[0]) * up[0], o1 = silu_f(gt[1]) * up[1], o2 = silu_f(gt[2]) * up[2], o3 = silu_f(gt[3]) * up[3];
                    const unsigned lo = pg8::cvt_pk_bf16(o0, o1), hi = pg8::cvt_pk_bf16(o2, o3);
                    if (n == 0) { w.x = lo; w.y = hi; } else { w.z = lo; w.w = hi; } }
                *(v4u*)(act + (size_t)row * DFF + col0) = w;
                EPI_FENCE(); }
    }
};
struct EpiPool {
    static constexpr bool PERM = true;
    bf16* cat; const float* scale;
    __device__ __forceinline__ void operator()(const f32x4 (&acc)[2][2][4][2], const pg8::Unit& u, int wr, int wc, int fr_, int fq_) const {
        int fr = fr_, fq = fq_; asm volatile("" : "+v"(fr), "+v"(fq));
        const int row0 = u.pm * 256 + wr * 64 + fr, col0 = u.pn * 256 + wc * 32 + 8 * fq;
#pragma unroll
        for (int bj = 0; bj < 2; ++bj) { const f32x4 s0 = *(const f32x4*)(scale + col0 + bj * 128), s1 = *(const f32x4*)(scale + col0 + bj * 128 + 4);
#pragma unroll
            for (int ai = 0; ai < 2; ++ai)
#pragma unroll
                for (int m = 0; m < 4; ++m) { bf16* rowp = cat + (size_t)(row0 + ai * 128 + m * 16) * DM + DNW + col0;
                    const f32x4 v0 = acc[ai][bj][m][0] * s0, v1 = acc[ai][bj][m][1] * s1;
                    v4u w; w.x = pg8::cvt_pk_bf16(v0[0], v0[1]); w.y = pg8::cvt_pk_bf16(v0[2], v0[3]); w.z = pg8::cvt_pk_bf16(v1[0], v1[1]); w.w = pg8::cvt_pk_bf16(v1[2], v1[3]);
                    *(v4u*)(rowp + bj * 128) = w; }
            EPI_FENCE(); }
    }
};

struct MixP {
    const bf16* proj; const float* ba; bf16* cat; const float *conv_w, *a_log, *dt_bias, *dn_norm;
};
__device__ __forceinline__ void delta_seq(LAS unsigned char* lds, const MixP& P, int row_base, int ntok_total, int h, const float* S0, const float* cstate  , float* Sout) {
    LAS float* qs = (LAS float*)lds; LAS float* ks = qs + 64 * 128; LAS float* vs = ks + 64 * 128; LAS float* os = vs + 64 * 128;
    LAS float* bt = os + 64 * 128; LAS float* egs = bt + 64;
    int tid_ = threadIdx.x; asm volatile("" : "+v"(tid_));
    const int tid = tid_, lane = tid & 63, wave = tid >> 6, vcol = tid >> 2, kq = tid & 3;
    float S[32];
#pragma unroll
    for (int i = 0; i < 32; ++i) S[i] = S0 ? S0[(size_t)(32 * kq + i) * 128 + vcol] : 0.f;
    const float Ah = __expf(P.a_log[h]), dtb = P.dt_bias[h];
    for (int t0 = 0; t0 < ntok_total; t0 += 64) {
        const int nt = (ntok_total - t0) < 64 ? (ntok_total - t0) : 64;
        for (int idx = tid; idx < nt * 384; idx += NTHR) {
            const int t = idx / 384, c = idx - t * 384, part = c >> 7, cc = c & 127, col = part * 1024 + h * 128 + cc; float y = 0.f;
#pragma unroll
            for (int i = 0; i < 4; ++i) { const int tt = t0 + t - 3 + i; float pv;
                if (tt >= 0) pv = bf2f(P.proj[(size_t)(row_base + tt) * PROJ_LD + col]); else pv = cstate ? cstate[(3 + tt) * 3072 + col] : 0.f;
                y += pv * P.conv_w[i * 3072 + col]; }
            y = silu_f(y);
            (part == 0 ? qs : (part == 1 ? ks : vs))[t * 128 + cc] = y;
        }
        if (tid < nt) { const int row = row_base + t0 + tid; const float braw = P.ba[(size_t)row * 16 + h], araw = P.ba[(size_t)row * 16 + 8 + h];
            bt[tid] = sigmoid_f(braw); egs[tid] = __expf(-Ah * softplus_f(araw + dtb)); }
        __syncthreads();
        for (int pr = wave; pr < 2 * nt; pr += NWAVES) { const int t = pr >> 1; LAS float* p = (pr & 1) ? ks : qs; const float a = p[t * 128 + lane], b = p[t * 128 + 64 + lane];
            const float ss = wave_sum(a * a + b * b); float sc = rsqrt_f(ss + EPS); if (!(pr & 1)) sc *= 0.08838834764831845f;
            p[t * 128 + lane] = a * sc; p[t * 128 + 64 + lane] = b * sc; }
        __syncthreads();
        for (int t = 0; t < nt; ++t) {
            const float eg = egs[t], beta = bt[t], vv = vs[t * 128 + vcol];
            const LAS f32x4* kp = (const LAS f32x4*)(ks + t * 128 + 32 * kq); const LAS f32x4* qp = (const LAS f32x4*)(qs + t * 128 + 32 * kq);
            float kr[32]; float kv = 0.f;
#pragma unroll
            for (int i = 0; i < 8; ++i) { const f32x4 k4 = kp[i]; kr[4 * i] = k4[0]; kr[4 * i + 1] = k4[1]; kr[4 * i + 2] = k4[2]; kr[4 * i + 3] = k4[3]; }
#pragma unroll
            for (int i = 0; i < 32; ++i) { S[i] *= eg; kv += kr[i] * S[i]; }
            kv += __shfl_xor(kv, 1); kv += __shfl_xor(kv, 2);
            const float dl = (vv - kv) * beta; float o = 0.f;
#pragma unroll
            for (int i = 0; i < 8; ++i) { const f32x4 q4 = qp[i];
                S[4 * i] += kr[4 * i] * dl; S[4 * i + 1] += kr[4 * i + 1] * dl; S[4 * i + 2] += kr[4 * i + 2] * dl; S[4 * i + 3] += kr[4 * i + 3] * dl;
                o += q4[0] * S[4 * i] + q4[1] * S[4 * i + 1] + q4[2] * S[4 * i + 2] + q4[3] * S[4 * i + 3]; }
            o += __shfl_xor(o, 1); o += __shfl_xor(o, 2);
            if (kq == 0) os[t * 128 + vcol] = o;
        }
        __syncthreads();
        for (int t = wave; t < nt; t += NWAVES) { const int row = row_base + t0 + t; const float a = os[t * 128 + lane], b = os[t * 128 + 64 + lane];
            const float ss = wave_sum(a * a + b * b); const float rs = rsqrt_f(ss * (1.0f / 128.f) + EPS);
            const float za = bf2f(P.proj[(size_t)row * PROJ_LD + 3072 + h * 128 + lane]), zb = bf2f(P.proj[(size_t)row * PROJ_LD + 3072 + h * 128 + 64 + lane]);
            P.cat[(size_t)row * DM + h * 128 + lane] = (bf16)f2bf(a * rs * P.dn_norm[lane] * silu_f(za));
            P.cat[(size_t)row * DM + h * 128 + 64 + lane] = (bf16)f2bf(b * rs * P.dn_norm[64 + lane] * silu_f(zb)); }
        __syncthreads();
    }
#pragma unroll
    for (int i = 0; i < 32; ++i) Sout[(size_t)(32 * kq + i) * 128 + vcol] = S[i];
}


typedef short bf16x8 __attribute__((ext_vector_type(8)));
#define BAR_LDS() do { asm volatile("s_waitcnt lgkmcnt(0)" ::: "memory"); __builtin_amdgcn_s_barrier(); asm volatile("" ::: "memory"); } while (0)
__device__ __forceinline__ bf16x8 frag_lds(const LAS bf16* base, int ld, int row0, int k0, int lane) { return *(const LAS bf16x8*)(base + (row0 + (lane & 15)) * ld + k0 + 8 * (lane >> 4)); }
__device__ __forceinline__ bf16x8 frag_glb(const bf16* base, int ld, int row0, int k0, int lane) { return *(const bf16x8*)(base + (size_t)(row0 + (lane & 15)) * ld + k0 + 8 * (lane >> 4)); }
#define MMA16(a, b, c) __builtin_amdgcn_mfma_f32_16x16x32_bf16((a), (b), (c), 0, 0, 0)
constexpr int PLD = 136;
constexpr int MLD = 68;
struct PrepP { const bf16* proj; const float* ba; const float *conv_w, *a_log, *dt_bias; bf16 *dW, *dQG, *dQK, *dKD; float *dU, *dEGL; };
constexpr int PREP_LDS = 71680;
__device__ __forceinline__ float rdlane(float v, int l) { return __builtin_bit_cast(float, __builtin_amdgcn_readlane(__builtin_bit_cast(int, v), l)); }
__device__ __forceinline__ void prep_pair(LAS unsigned char* lds, const PrepP& P, int u0, int u1) {
    int tid_ = threadIdx.x; asm volatile("" : "+v"(tid_));
    const int tid = tid_, lane = tid & 63, wave = __builtin_amdgcn_readfirstlane(tid >> 6), g = wave >> 2, lw = wave & 3, lt = tid & 255;
    { unsigned lb_ = (unsigned)(size_t)lds + (unsigned)g * PREP_LDS; asm volatile("" : "+v"(lb_)); lds = (LAS unsigned char*)(size_t)lb_; }
    LAS bf16* Qr = (LAS bf16*)lds;
    LAS bf16* Kr = Qr + 64 * PLD;
    LAS float* Mf = (LAS float*)(Kr + 64 * PLD);
    LAS float* ssk = Mf + 64 * MLD; LAS float* ssq = ssk + 64;
    LAS float* rkv = ssq + 64; LAS float* rqv = rkv + 64;
    LAS float* sbeta = rqv + 64; LAS float* sgc = sbeta + 64; LAS float* segc = sgc + 64; LAS float* sekd = segc + 64;
    const int u = g ? u1 : u0, c = u & 31, bh = u >> 5, b = bh >> 3, h = bh & 7, row0 = b * SEQ + c * 64;
    const bool isk = lt < 128; const int cc = lt & 127, th = lt >> 7;
    typedef float f32x2 __attribute__((ext_vector_type(2)));
    f32x2 xp[32]; float xq[32];
#define X(t) xp[(t) >> 1][(t) & 1]
    if (lw == 3) {
        const float Ah = __expf(P.a_log[h]), dtb = P.dt_bias[h];
        const float braw = P.ba[(size_t)(row0 + lane) * 16 + h], araw = P.ba[(size_t)(row0 + lane) * 16 + 8 + h];
        const float beta = sigmoid_f(braw), gg = -Ah * softplus_f(araw + dtb);
        float gc = gg;
#pragma unroll
        for (int o = 1; o < 64; o <<= 1) { const float v = __shfl_up(gc, o); if (lane >= o) gc += v; }
        const float gl = __shfl(gc, 63);
        sbeta[lane] = beta; sgc[lane] = gc; segc[lane] = __expf(gc); sekd[lane] = __expf(gl - gc);
        if (lane == 0) P.dEGL[u] = __expf(gl);
    }
    {
        const int col = (isk ? 1024 : 2048) + h * 128 + cc;
        const float w0 = P.conv_w[col], w1 = P.conv_w[3072 + col], w2 = P.conv_w[2 * 3072 + col], w3 = P.conv_w[3 * 3072 + col];
        const bf16* pp = P.proj + (size_t)row0 * PROJ_LD + col;
        float pm3 = 0.f, pm2 = 0.f, pm1 = 0.f;
        if (c > 0) { pm3 = bf2f(pp[-3 * PROJ_LD]); pm2 = bf2f(pp[-2 * PROJ_LD]); pm1 = bf2f(pp[-1 * PROJ_LD]); }
#pragma unroll
        for (int t = 0; t < 64; ++t) { const float pc = bf2f(pp[(size_t)t * PROJ_LD]); X(t) = silu_f(w0 * pm3 + w1 * pm2 + w2 * pm1 + w3 * pc); pm3 = pm2; pm2 = pm1; pm1 = pc; }
        if (isk) {
#pragma unroll
            for (int t = 0; t < 64; ++t) Kr[t * PLD + cc] = (bf16)f2bf(X(t)); }
    }
    {
        const int col = h * 128 + cc;
        const float w0 = P.conv_w[col], w1 = P.conv_w[3072 + col], w2 = P.conv_w[2 * 3072 + col], w3 = P.conv_w[3 * 3072 + col];
        const bf16* pp = P.proj + (size_t)(row0 + 32 * th) * PROJ_LD + col;
        float pm3 = 0.f, pm2 = 0.f, pm1 = 0.f;
        if (c > 0 || th > 0) { pm3 = bf2f(pp[-3 * PROJ_LD]); pm2 = bf2f(pp[-2 * PROJ_LD]); pm1 = bf2f(pp[-1 * PROJ_LD]); }
#pragma unroll
        for (int t = 0; t < 32; ++t) { const float pc = bf2f(pp[(size_t)t * PROJ_LD]); xq[t] = silu_f(w0 * pm3 + w1 * pm2 + w2 * pm1 + w3 * pc); pm3 = pm2; pm2 = pm1; pm1 = pc;
            Qr[(32 * th + t) * PLD + cc] = (bf16)f2bf(xq[t]); }
    }
    BAR_LDS();
    const int fr = lane & 15, fq = lane >> 4;
    f32x4 tacc[6];
#pragma unroll
    for (int n = 0; n < 6; ++n) {
        const int e = lw * 6 + n, ty = e < 10 ? 0 : (e < 20 ? 1 : 2), pidx = ty == 0 ? e : (ty == 1 ? e - 10 : 0);
        const int ti = ty == 2 ? e - 20 : (pidx >= 6 ? 3 : (pidx >= 3 ? 2 : (pidx >= 1 ? 1 : 0))), tj = ty == 2 ? ti : pidx - ti * (ti + 1) / 2;
        const LAS bf16* Xa = ty == 0 ? Kr : Qr; const LAS bf16* Xb = ty == 2 ? Qr : Kr;
        f32x4 acc = (f32x4){0.f, 0.f, 0.f, 0.f};
#pragma unroll
        for (int ks = 0; ks < 4; ++ks) acc = MMA16(frag_lds(Xb, PLD, 16 * tj, 32 * ks, lane), frag_lds(Xa, PLD, 16 * ti, 32 * ks, lane), acc);
        tacc[n] = acc;
        if (ti == tj && ty != 1 && (fr >> 2) == fq) { const int jj = fr & 3; const float d = jj == 0 ? acc[0] : (jj == 1 ? acc[1] : (jj == 2 ? acc[2] : acc[3])); (ty == 0 ? ssk : ssq)[16 * ti + fr] = d; }
    }
    BAR_LDS();
    const float rk_l = rsqrt_f(ssk[lane] + EPS), rq_l = rsqrt_f(ssq[lane] + EPS) * 0.08838834764831845f, bet_l = sbeta[lane], egc_l = segc[lane];
    const float cq_l = rq_l * egc_l, ckd_l = rk_l * sekd[lane], ckb_l = rk_l * bet_l * egc_l;
    rkv[lane] = rk_l; rqv[lane] = rq_l;
    asm volatile("s_waitcnt lgkmcnt(0)" ::: "memory");
#pragma unroll
    for (int n = 0; n < 6; ++n) {
        const int e = lw * 6 + n, ty = e < 10 ? 0 : (e < 20 ? 1 : 2), pidx = ty == 0 ? e : (ty == 1 ? e - 10 : 0);
        const int ti = ty == 2 ? e - 20 : (pidx >= 6 ? 3 : (pidx >= 3 ? 2 : (pidx >= 1 ? 1 : 0))), tj = ty == 2 ? ti : pidx - ti * (ti + 1) / 2;
        if (ty < 2) {
            const int i = 16 * ti + fr, j0 = 16 * tj + 4 * fq; const float gi = sgc[i]; const float pre = ty == 0 ? sbeta[i] * rkv[i] : rqv[i];
            const f32x4 rj = *(const LAS f32x4*)(rkv + j0), gj = *(const LAS f32x4*)(sgc + j0);
            float o[4];
#pragma unroll
            for (int jj = 0; jj < 4; ++jj) { const int j = j0 + jj; const float dec = __expf(gi - gj[jj]); const bool keep = ty ? (i >= j) : (i > j); o[jj] = keep ? tacc[n][jj] * pre * rj[jj] * dec : 0.f; }
            if (ty) { v2u w; w.x = pk2(o[0], o[1]); w.y = pk2(o[2], o[3]); *(v2u*)(P.dQK + (size_t)u * 4096 + ((ti * 2 + (tj >> 1)) * 64 + ((2 * tj + (fq >> 1)) & 3) * 16 + fr) * 8 + 4 * (fq & 1)) = w; }
            else *(LAS f32x4*)(Mf + i * MLD + j0) = (f32x4){o[0], o[1], o[2], o[3]};
        }
    }
    {
#pragma unroll
        for (int n = 0; n < 3; ++n) { const int z = lw * 3 + n, ty = z / 6, p6 = z % 6;
            const int ti = p6 < 3 ? 0 : (p6 < 5 ? 1 : 2), tj = p6 < 3 ? p6 + 1 : (p6 < 5 ? p6 - 1 : 3);
            const int i = 16 * ti + fr, j0 = 16 * tj + 4 * fq;
            if (ty) { v2u w; w.x = 0u; w.y = 0u; *(v2u*)(P.dQK + (size_t)u * 4096 + ((ti * 2 + (tj >> 1)) * 64 + ((2 * tj + (fq >> 1)) & 3) * 16 + fr) * 8 + 4 * (fq & 1)) = w; }
            else *(LAS f32x4*)(Mf + i * MLD + j0) = (f32x4){0.f, 0.f, 0.f, 0.f}; }
    }
    if (isk) {
        bf16* kd = P.dKD + (size_t)u * 8192 + (size_t)(cc >> 4) * 1024 + (cc & 15) * 8;
        unsigned pk[32];
#pragma unroll
        for (int t = 0; t < 64; ++t) { const unsigned kdv = f2bf(X(t) * rdlane(ckd_l, t)); if (t & 1) pk[t >> 1] |= kdv << 16; else pk[t >> 1] = kdv; X(t) *= rdlane(ckb_l, t); }
#pragma unroll
        for (int i = 0; i < 8; ++i) { v4u o; o.x = pk[4 * i]; o.y = pk[4 * i + 1]; o.z = pk[4 * i + 2]; o.w = pk[4 * i + 3]; *(v4u*)(kd + (i >> 2) * 512 + (i & 3) * 128) = o; }
    } else {
#pragma unroll
        for (int t = 0; t < 64; ++t) X(t) *= rdlane(bet_l, t);
    }
    BAR_LDS();
#pragma unroll
    for (int i = 1; i < 64; ++i) { f32x2 a01 = (f32x2){X(i), 0.f}, a23 = (f32x2){0.f, 0.f};
#pragma unroll
        for (int jg = 0; 4 * jg < i; ++jg) { const f32x4 m = *(const LAS f32x4*)(Mf + i * MLD + 4 * jg);
            a01 -= (f32x2){m[0], m[1]} * xp[2 * jg]; a23 -= (f32x2){m[2], m[3]} * xp[2 * jg + 1]; }
        const f32x2 sm = a01 + a23; X(i) = sm[0] + sm[1]; }
    if (isk) {
#pragma unroll
        for (int t = 0; t < 64; ++t) Kr[t * PLD + cc] = (bf16)f2bf(X(t));
    } else { float* up = P.dU + (size_t)u * 8192 + (size_t)(cc >> 4) * 1024 + (cc & 15) * 4;
#pragma unroll
        for (int i = 0; i < 16; ++i) *(f32x4*)(up + (i >> 2) * 256 + (i & 3) * 64) = (f32x4){X(4 * i), X(4 * i + 1), X(4 * i + 2), X(4 * i + 3)}; }
#pragma unroll
    for (int t = 0; t < 32; ++t) { const int tt = 32 * th + t; Qr[tt * PLD + cc] = (bf16)f2bf(xq[t] * rdlane(cq_l, tt)); }
    BAR_LDS();
#pragma unroll
    for (int i = 0; i < 4; ++i) { const int pz = (lw * 4 + i) * 64 + lane; const int rb = pz >> 8, ks = (pz >> 6) & 3, t = rb * 16 + (lane & 15), d0 = ks * 32 + (lane >> 4) * 8;
        *(v4u*)(P.dW + (size_t)u * 8192 + (size_t)pz * 8) = *(const LAS v4u*)(Kr + t * PLD + d0);
        *(v4u*)(P.dQG + (size_t)u * 8192 + (size_t)pz * 8) = *(const LAS v4u*)(Qr + t * PLD + d0); }
    BAR_LDS();
}
#undef X
struct ScanP { const bf16 *dW, *dQG, *dQK, *dKD; const float *dU, *dEGL; float *ob, *ossq, *sout; };
constexpr int VLD = 72;
template <bool LOW>
__device__ __forceinline__ void scan_loop(LAS bf16* St, LAS bf16* Vt, const ScanP& P, int bh, int sl, int wave, int lane, f32x4& S) {
    const int fr = lane & 15, fq = lane >> 4, rb = wave & 3, e0 = sl * 16, b = bh / NH, h = bh % NH;
    const size_t u0 = (size_t)bh * (SEQ / 64);
    struct Ops { bf16x8 A1[4], K2[2], QK[2]; f32x4 Uv; float egl; };
    Ops R0, R1, R2, R3;
#define SCAN_LOAD(o, cc) do { const size_t u_ = u0 + ((cc) < SEQ / 64 ? (cc) : SEQ / 64 - 1); const bf16* a1 = (LOW ? P.dW : P.dQG) + u_ * 8192; \
        _Pragma("unroll") for (int ks = 0; ks < 4; ++ks) (o).A1[ks] = *(const bf16x8*)(a1 + ((rb * 4 + ks) * 64 + lane) * 8); \
        _Pragma("unroll") for (int ks = 0; ks < 2; ++ks) (o).K2[ks] = *(const bf16x8*)(P.dKD + u_ * 8192 + ((wave * 2 + ks) * 64 + lane) * 8); \
        if (LOW) (o).Uv = *(const f32x4*)(P.dU + u_ * 8192 + ((sl * 4 + rb) * 64 + lane) * 4); \
        else { _Pragma("unroll") for (int ks = 0; ks < 2; ++ks) (o).QK[ks] = *(const bf16x8*)(P.dQK + u_ * 4096 + ((rb * 2 + ks) * 64 + lane) * 8); } \
        (o).egl = P.dEGL[u_]; } while (0)
#define SCAN_STEP(cur, nxt, c) do { SCAN_LOAD(nxt, (c) + 3); \
        f32x4 acc = (f32x4){0.f, 0.f, 0.f, 0.f}; \
        _Pragma("unroll") for (int ks = 0; ks < 4; ++ks) acc = MMA16((cur).A1[ks], frag_lds(St, PLD, 0, 32 * ks, lane), acc); \
        if (LOW) { const f32x4 vn = (cur).Uv - acc; v2u w; w.x = pk2(vn[0], vn[1]); w.y = pk2(vn[2], vn[3]); *(LAS v2u*)(Vt + fr * VLD + 16 * rb + 4 * fq) = w; } \
        BAR_LDS(); \
        const bf16x8 v0 = frag_lds(Vt, VLD, 0, 0, lane), v1 = frag_lds(Vt, VLD, 0, 32, lane); \
        if (!LOW) { acc = MMA16((cur).QK[0], v0, acc); acc = MMA16((cur).QK[1], v1, acc); \
            const int row = b * SEQ + (c) * 64 + 16 * rb + 4 * fq; float* op = P.ob + (size_t)row * DNW + h * 128 + e0 + fr; \
            _Pragma("unroll") for (int j = 0; j < 4; ++j) __hip_atomic_store(op + (size_t)j * DNW, acc[j], __ATOMIC_RELAXED, __HIP_MEMORY_SCOPE_AGENT); }     \
        S = S * (cur).egl; S = MMA16((cur).K2[0], v0, S); S = MMA16((cur).K2[1], v1, S); \
        { v2u w; w.x = pk2(S[0], S[1]); w.y = pk2(S[2], S[3]); *(LAS v2u*)(St + fr * PLD + 16 * wave + 4 * fq) = w; } \
        BAR_LDS(); } while (0)
    SCAN_LOAD(R0, 0); SCAN_LOAD(R1, 1); SCAN_LOAD(R2, 2);
    for (int c0 = 0; c0 < SEQ / 64; c0 += 4) { SCAN_STEP(R0, R3, c0); SCAN_STEP(R1, R0, c0 + 1); SCAN_STEP(R2, R1, c0 + 2); SCAN_STEP(R3, R2, c0 + 3); }
#undef SCAN_STEP
#undef SCAN_LOAD
}
__device__ __forceinline__ void scan_item(LAS unsigned char* lds, const ScanP& P, int bh, int sl) {
    LAS bf16* St = (LAS bf16*)lds;
    LAS bf16* Vt = St + 16 * PLD;
    int tid_ = threadIdx.x; asm volatile("" : "+v"(tid_));
    const int tid = tid_, lane = tid & 63, wave = __builtin_amdgcn_readfirstlane(tid >> 6), fr = lane & 15, fq = lane >> 4;
    for (int i = tid; i < 16 * PLD / 2; i += NTHR) ((LAS unsigned*)St)[i] = 0u;
    f32x4 S = (f32x4){0.f, 0.f, 0.f, 0.f};
    BAR_LDS();
    if (wave < 4) scan_loop<true>(St, Vt, P, bh, sl, wave, lane, S); else scan_loop<false>(St, Vt, P, bh, sl, wave, lane, S);
    float* so = P.sout + (size_t)bh * 16384 + (size_t)(16 * wave + 4 * fq) * 128 + sl * 16 + fr;
#pragma unroll
    for (int j = 0; j < 4; ++j) so[j * 128] = S[j];
}

constexpr int SK_SLOT = 20480;
__device__ __forceinline__ void skinny2_mma(LAS unsigned char* lds, const bf16* A, int lda, const bf16* Bt, int ldb, int K, int brow0, int brow1, f32x4 (&acc)[2]) {
    int tid_ = threadIdx.x; asm volatile("" : "+v"(tid_));
    const int tid = tid_, lane = tid & 63, wave = __builtin_amdgcn_readfirstlane(tid >> 6), fr = lane & 15, fq = lane >> 4;
    unsigned voffA[2], voffB;
#pragma unroll
    for (int i = 0; i < 2; ++i) { int R, C; pg8::stage_rc(tid * 16 + i * 8192, R, C); voffA[i] = (unsigned)(R * lda + C) * 2u; }
    { int R, C; pg8::stage_rc((tid & 255) * 16, R, C); voffB = (unsigned)((R < 16 ? brow0 + R : brow1 + R - 16) * ldb + C) * 2u; }
    const unsigned ldswA = (unsigned)wave * 1024u, ldswB = 16384u + (unsigned)(wave & 3) * 1024u;
    int aoff[2], boff[2][2];
#pragma unroll
    for (int ks = 0; ks < 2; ++ks) { aoff[ks] = pg8::lds_byte(16 * wave + fr, 32 * ks + 8 * fq); boff[0][ks] = 16384 + pg8::lds_byte(fr, 32 * ks + 8 * fq); boff[1][ks] = 16384 + pg8::lds_byte(16 + fr, 32 * ks + 8 * fq); }
    const int nt = K / 64;
#define SK_STAGE(kt_, slot_) do { const char* ga = (const char*)A + (size_t)(kt_) * 128; const char* gb = (const char*)Bt + (size_t)(kt_) * 128; LAS unsigned char* sl_ = lds + (slot_) * SK_SLOT; \
        _Pragma("unroll") for (int _i = 0; _i < 2; ++_i) { unsigned vo = voffA[_i]; asm volatile("" : "+v"(vo)); __builtin_amdgcn_global_load_lds((const unsigned*)(ga + vo), (LAS unsigned*)(sl_ + ldswA + _i * 8192), 16, 0, 0); } \
        { unsigned vo = voffB; asm volatile("" : "+v"(vo)); __builtin_amdgcn_global_load_lds((const unsigned*)(gb + vo), (LAS unsigned*)(sl_ + ldswB), 16, 0, 0); } } while (0)
    acc[0] = (f32x4){0.f, 0.f, 0.f, 0.f}; acc[1] = (f32x4){0.f, 0.f, 0.f, 0.f};
    SK_STAGE(0, 0); SK_STAGE(1, 1); SK_STAGE(2, 2);
    for (int kt = 0; kt < nt; ++kt) {
        asm volatile("s_waitcnt vmcnt(6)" ::: "memory");
        __builtin_amdgcn_s_barrier(); asm volatile("" ::: "memory");
        { const int k3 = kt + 3 < nt ? kt + 3 : 0; SK_STAGE(k3, (kt + 3) & 3); }
        const LAS unsigned char* sl = lds + (kt & 3) * SK_SLOT;
#pragma unroll
        for (int ks = 0; ks < 2; ++ks) { const bf16x8 a = *(const LAS bf16x8*)(sl + aoff[ks]), b0 = *(const LAS bf16x8*)(sl + boff[0][ks]), b1 = *(const LAS bf16x8*)(sl + boff[1][ks]);
            acc[0] = MMA16(b0, a, acc[0]); acc[1] = MMA16(b1, a, acc[1]); }
        asm volatile("s_waitcnt lgkmcnt(0)" ::: "memory");
    }
    asm volatile("s_waitcnt vmcnt(0)" ::: "memory");
    __builtin_amdgcn_s_barrier(); asm volatile("" ::: "memory");
#undef SK_STAGE
}
__device__ __forceinline__ void short_blocks(int nwg, int G, int c, int& si, int& nshort) {
    const int rounds = (nwg + G - 1) / G, full = nwg - (rounds - 1) * G;
    if (full == G) { nshort = G; si = c; } else { nshort = G - full; si = c - full; }
}
__device__ __forceinline__ float dec_row_scale(const float* dssq, int r) {
    const f32x4* p = (const f32x4*)(dssq + (size_t)r * 64); float s = 0.f;
#pragma unroll
    for (int i = 0; i < 16; ++i) { const f32x4 v = p[i]; s += (v[0] + v[1]) + (v[2] + v[3]); }
    return rsqrt_f(s * (1.0f / DM) + EPS);
}
constexpr int SK8_SLOT = 32768;
template <bool GU>
__device__ __forceinline__ void skinny128_mma(LAS unsigned char* lds, const bf16* A, int lda, const bf16* Bt, int ldb, int K, int brow0, f32x4 (&acc)[8]) {
    int tid_ = threadIdx.x; asm volatile("" : "+v"(tid_));
    const int tid = tid_, lane = tid & 63, wave = __builtin_amdgcn_readfirstlane(tid >> 6), fr = lane & 15, fq = lane >> 4;
    unsigned voffA[2], voffB[2];
#pragma unroll
    for (int i = 0; i < 2; ++i) { int R, C; pg8::stage_rc(tid * 16 + i * 8192, R, C); voffA[i] = (unsigned)(R * lda + C) * 2u;
        const int rowb = GU ? (R < 64 ? brow0 + R : brow0 + 128 + (R - 64)) : brow0 + R; voffB[i] = (unsigned)(rowb * ldb + C) * 2u; }
    const unsigned ldsw = (unsigned)wave * 1024u;
    int aoff[2], boff[2];
#pragma unroll
    for (int ks = 0; ks < 2; ++ks) { aoff[ks] = pg8::lds_byte(16 * wave + fr, 32 * ks + 8 * fq); boff[ks] = 16384 + pg8::lds_byte(fr, 32 * ks + 8 * fq); }
    const int nt = K / 64;
#define SK8_STAGE(kt_, slot_) do { const char* ga = (const char*)A + (size_t)(kt_) * 128; const char* gb = (const char*)Bt + (size_t)(kt_) * 128; LAS unsigned char* sl_ = lds + (slot_) * SK8_SLOT; \
        _Pragma("unroll") for (int _i = 0; _i < 2; ++_i) { unsigned vo = voffA[_i]; asm volatile("" : "+v"(vo)); __builtin_amdgcn_global_load_lds((const unsigned*)(ga + vo), (LAS unsigned*)(sl_ + ldsw + _i * 8192), 16, 0, 0); } \
        _Pragma("unroll") for (int _i = 0; _i < 2; ++_i) { unsigned vo = voffB[_i]; asm volatile("" : "+v"(vo)); __builtin_amdgcn_global_load_lds((const unsigned*)(gb + vo), (LAS unsigned*)(sl_ + 16384 + ldsw + _i * 8192), 16, 0, 0); } } while (0)
#pragma unroll
    for (int nb = 0; nb < 8; ++nb) acc[nb] = (f32x4){0.f, 0.f, 0.f, 0.f};
    SK8_STAGE(0, 0); SK8_STAGE(1, 1); SK8_STAGE(2, 2);
    for (int kt = 0; kt < nt; ++kt) {
        asm volatile("s_waitcnt vmcnt(8)" ::: "memory");
        __builtin_amdgcn_s_barrier(); asm volatile("" ::: "memory");
        { const int k3 = kt + 3 < nt ? kt + 3 : 0; SK8_STAGE(k3, (kt + 3) & 3); }
        const LAS unsigned char* sl = lds + (kt & 3) * SK8_SLOT;
#pragma unroll
        for (int ks = 0; ks < 2; ++ks) { const bf16x8 a = *(const LAS bf16x8*)(sl + aoff[ks]);
#pragma unroll
            for (int nb = 0; nb < 8; ++nb) { const bf16x8 bq = *(const LAS bf16x8*)(sl + boff[ks] + nb * 2048); acc[nb] = MMA16(bq, a, acc[nb]); } }
        asm volatile("s_waitcnt lgkmcnt(0)" ::: "memory");
    }
    asm volatile("s_waitcnt vmcnt(0)" ::: "memory");
    __builtin_amdgcn_s_barrier(); asm volatile("" ::: "memory");
#undef SK8_STAGE
}
__device__ __forceinline__ void dec_in_tiles(LAS unsigned char* lds, const bf16* HB, const bf16* Bt, bf16* proj, float* ba, const float* dssq, int si, int nshort) {
    if (si < 0) return;
    int tl = threadIdx.x; asm volatile("" : "+v"(tl)); const int lane = tl & 63, wave = __builtin_amdgcn_readfirstlane(tl >> 6), r = 16 * wave + (lane & 15), q = lane >> 4;
    for (int t = si; t < 41; t += nshort) {
        f32x4 acc[8];
        skinny128_mma<false>(lds, HB + (size_t)MP * DM, DM, Bt, DM, DM, 128 * t, acc);
        const float rs = dec_row_scale(dssq, r);
        if (t < 40) {
#pragma unroll
            for (int nb = 0; nb < 8; ++nb) { const f32x4 v = acc[nb] * rs; v2u w; w.x = pk2(v[0], v[1]); w.y = pk2(v[2], v[3]); *(v2u*)(proj + (size_t)(MP + r) * PROJ_LD + 128 * t + 16 * nb + 4 * q) = w; }
        } else *(f32x4*)(ba + (size_t)(MP + r) * 16 + 4 * q) = acc[0] * rs;
    }
}
__device__ __forceinline__ void dec_res_tiles(LAS unsigned char* lds, const bf16* A, int K, const bf16* Bt, bf16* hb, float* dssq, int si, int nshort) {
    if (si < 0) return;
    int tl = threadIdx.x; asm volatile("" : "+v"(tl)); const int lane = tl & 63, wave = __builtin_amdgcn_readfirstlane(tl >> 6), r = 16 * wave + (lane & 15), q = lane >> 4;
    for (int t = si; t < 64; t += nshort) {
        f32x4 acc[2];
        skinny2_mma(lds, A + (size_t)MP * K, K, Bt, K, K, 32 * t, 32 * t + 16, acc);
        float sq = 0.f;
#pragma unroll
        for (int nb = 0; nb < 2; ++nb) { bf16* hp = hb + (size_t)(MP + r) * DM + 32 * t + 16 * nb + 4 * q; const v2u o = *(const v2u*)hp; f32x4 v = acc[nb];
            v[0] += __builtin_bit_cast(float, o.x << 16); v[1] += __builtin_bit_cast(float, o.x & 0xffff0000u); v[2] += __builtin_bit_cast(float, o.y << 16); v[3] += __builtin_bit_cast(float, o.y & 0xffff0000u);
            v2u w; w.x = pk2(v[0], v[1]); w.y = pk2(v[2], v[3]); *(v2u*)hp = w;
            sq += (v[0] * v[0] + v[1] * v[1]) + (v[2] * v[2] + v[3] * v[3]); }
        sq += __shfl_xor(sq, 16); sq += __shfl_xor(sq, 32);
        if (q == 0) dssq[(size_t)r * 64 + t] = sq;
    }
}
__device__ __forceinline__ void dec_gu_tiles(LAS unsigned char* lds, const bf16* HB, const bf16* Bt, bf16* act, const float* dssq, int si, int nshort) {
    if (si < 0) return;
    int tl = threadIdx.x; asm volatile("" : "+v"(tl)); const int lane = tl & 63, wave = __builtin_amdgcn_readfirstlane(tl >> 6), r = 16 * wave + (lane & 15), q = lane >> 4;
    for (int t = si; t < DFF / 64; t += nshort) {
        const int c0 = 64 * t, g0 = (c0 >> 7) * 256 + (c0 & 127); f32x4 acc[8];
        skinny128_mma<true>(lds, HB + (size_t)MP * DM, DM, Bt, DM, DM, g0, acc);
        const float rs = dec_row_scale(dssq, r);
#pragma unroll
        for (int nb = 0; nb < 4; ++nb) { const f32x4 gt = acc[nb] * rs, up = acc[nb + 4] * rs;
            v2u w; w.x = pk2(silu_f(gt[0]) * up[0], silu_f(gt[1]) * up[1]); w.y = pk2(silu_f(gt[2]) * up[2], silu_f(gt[3]) * up[3]);
            *(v2u*)(act + (size_t)(MP + r) * DFF + c0 + 16 * nb + 4 * q) = w; }
    }
}

#ifndef AL_IN
#define AL_IN true
#define SP_IN true
#define AL_POOL true
#define SP_POOL true
#define AL_RES true
#define SP_RES true
#define AL_GU true
#define SP_GU true
#endif
__device__ __forceinline__ void ph_gemm_in(LAS unsigned char* lds, const bf16* A, const bf16* Bt, bf16* proj, float* ba, const float* ssq, int G, int bid) {
    pg8::Gemm g{A, Bt, MP, NIN, DM, DM, DM, 0}; pg8::StaticOrder S; S.init(MP, NIN, G, bid); EpiIn E{proj, ba, ssq};
    pg8::gemm_phase<EpiIn, pg8::StaticOrder, AL_IN, SP_IN>(lds, g, S, E);
}
__device__ __forceinline__ void ph_gemm_pool(LAS unsigned char* lds, const bf16* A, const bf16* Bt, bf16* cat, const float* scale, int G, int bid) {
    pg8::Gemm g{A, Bt, MPAD, 1024, 256, POOLW, 256, 512}; pg8::StaticOrder S; S.init(MPAD, 1024, G, bid); EpiPool E{cat, scale};
    pg8::gemm_phase<EpiPool, pg8::StaticOrder, AL_POOL, SP_POOL>(lds, g, S, E);
}
__device__ __forceinline__ void ph_gemm_res(LAS unsigned char* lds, const bf16* A, const bf16* Bt, int K, bf16* hb, float* ssq, int G, int bid) {
    pg8::Gemm g{A, Bt, MP, DM, K, K, K, 0}; pg8::StaticOrder S; S.init(MP, DM, G, bid); EpiRes E{hb, ssq};
    pg8::gemm_phase<EpiRes, pg8::StaticOrder, AL_RES, SP_RES>(lds, g, S, E);
}
__device__ __forceinline__ void ph_gemm_gu(LAS unsigned char* lds, const bf16* A, const bf16* Bt, bf16* act, const float* ssq, int G, int bid) {
    pg8::Gemm g{A, Bt, MP, 2 * DFF, DM, DM, DM, 0}; pg8::StaticOrder S; S.init(MP, 2 * DFF, G, bid); EpiSwiGLU E{act, ssq};
    pg8::gemm_phase<EpiSwiGLU, pg8::StaticOrder, AL_GU, SP_GU>(lds, g, S, E);
}

constexpr int N_PHASES = 2 + 6 * DEPTH;
typedef const Args __attribute__((address_space(4)))* KArgs;
__device__ __forceinline__ KArgs kargs_() { KArgs p = (KArgs)__builtin_amdgcn_kernarg_segment_ptr(); asm volatile("" : "+s"(p)); return p; }
#define KA (kargs_())
#define IN(k) (lo <= (k) && (k) < hi)
#define SEAM(k) do { if (IN(k) && IN((k) + 1)) { XcdBarrier bar_; bar_.bar = (unsigned*)(KA->ws + WS_CTL) + CW_BAR; bar_.x = xb_xcc_id(); bar_.st = (volatile LAS unsigned*)(lds + MISC_OFF) + 8; xcd_barrier(bar_); } } while (0)
#define WSP(T, off) ((T*)(ka->ws + (off)))
#define PHASE_PTRS() const KArgs ka = KA; bf16* const WinT = WSP(bf16, WS_WIN); bf16* const WoutT = WSP(bf16, WS_WOUT); bf16* const WguT = WSP(bf16, WS_WGU); bf16* const WdT = WSP(bf16, WS_WD); bf16* const WpT = WSP(bf16, WS_WP); \
    float* const H = WSP(float, WS_H); bf16* const HB = WSP(bf16, WS_HB); bf16* const PROJ = WSP(bf16, WS_PROJ); float* const BA = WSP(float, WS_BA); \
    bf16* const CAT = WSP(bf16, WS_CAT); bf16* const DB = WSP(bf16, WS_DB); bf16* const ACT = WSP(bf16, WS_ACT); float* const SSQ = WSP(float, WS_SSQ); \
    (void)WinT; (void)WoutT; (void)WguT; (void)WdT; (void)WpT; (void)H; (void)HB; (void)PROJ; (void)BA; (void)CAT; (void)DB; (void)ACT; (void)SSQ
template <int l> __device__ __forceinline__ void layer_phases(LAS unsigned char* lds, const int lo, const int hi, const int G, const int bid) {
        const int p0 = 1 + 6 * l;
        if (IN(p0)) {
            PHASE_PTRS();
            ph_gemm_in(lds, HB, WinT + (size_t)l * NIN * DM, PROJ, BA, SSQ, G, bid);
            { int si, ns; short_blocks((MP / 256) * (NIN / 256), G, bid, si, ns); dec_in_tiles(lds, HB, WinT + (size_t)l * NIN * DM, PROJ, BA, WSP(float, WS_DSSQ), si, ns);
              if (l + 1 < DEPTH && G == 256) { const CvP CV{ka->w_in, ka->norm_mix, ka->w_out, ka->w_gate_up, ka->norm_ffn, ka->w_down, ka->w_pool, WinT, WoutT, WguT, WdT, WpT}; convert_tail(CV, lds, l + 1, 0, si, ns, CV_A); } }
        }
        SEAM(p0);
        if (IN(p0 + 1)) {
            PHASE_PTRS();
            {
                PrepP PP{PROJ, BA, ka->conv_w + (size_t)l * 4 * 3072, ka->a_log + l * NH, ka->dt_bias + l * NH, WSP(bf16, WS_DW), WSP(bf16, WS_DQG), WSP(bf16, WS_DQK), WSP(bf16, WS_DKD), WSP(float, WS_DU), WSP(float, WS_EGL)};
                for (int u = bid; u < NUNIT; u += 2 * G) prep_pair(lds, PP, u, u + G < NUNIT ? u + G : u);
            }
            {
                MixP P{PROJ, BA, CAT, ka->conv_w + (size_t)l * 4 * 3072, ka->a_log + l * NH, ka->dt_bias + l * NH, ka->dn_norm + l * HD};
                const int wb = bid, nW = G;
                for (int it = wb; it < DECB * NH; it += nW) { const int b = it / NH, h = it % NH;
                    delta_seq(lds, P, MP + b, 1, h, ka->state_delta + ((size_t)(l * DECB + b) * NH + h) * 16384, ka->state_conv + (size_t)(l * DECB + b) * 3 * 3072, ka->out + O_DS + ((size_t)(l * DECB + b) * NH + h) * 16384); }
                int tl = threadIdx.x; asm volatile("" : "+v"(tl));
                const size_t gt = (size_t)wb * NTHR + tl, gs = (size_t)nW * NTHR;
                for (size_t it = gt; it < (size_t)(MP / 64) * POOLW; it += gs) {
                    const int c = (int)(it & 1023), chunk = (int)(it >> 10), rowb = chunk * 64, t0 = (chunk & 31) * 64, grp = c >> 8;
                    const bf16* pp = PROJ + (size_t)rowb * PROJ_LD + 4096 + c; bf16* dp = DB + (size_t)rowb * POOLW + c;
                    float w[16];
                    w[0] = 0.f;
#pragma unroll
                    for (int j = 0; j < 15; ++j) w[j + 1] = (t0 > 0) ? bf2f(pp[(long)(j - 15) * PROJ_LD]) : 0.f;
#pragma unroll
                    for (int t = 0; t < 64; ++t) {
                        w[t & 15] = bf2f(pp[(size_t)t * PROJ_LD]);
                        const float s2 = w[t & 15] + w[(t - 1) & 15];
                        const float s4 = s2 + (w[(t - 2) & 15] + w[(t - 3) & 15]);
                        const float s8 = s4 + ((w[(t - 4) & 15] + w[(t - 5) & 15]) + (w[(t - 6) & 15] + w[(t - 7) & 15]));
                        const float s16 = s8 + (((w[(t - 8) & 15] + w[(t - 9) & 15]) + (w[(t - 10) & 15] + w[(t - 11) & 15])) + ((w[(t - 12) & 15] + w[(t - 13) & 15]) + (w[(t - 14) & 15] + w[(t - 15) & 15])));
                        const float ssum = grp == 0 ? s2 : (grp == 1 ? s4 : (grp == 2 ? s8 : s16)); const int win = 2 << grp;
                        const int n = (t0 + t + 1) < win ? (t0 + t + 1) : win;
                        dp[(size_t)t * POOLW] = (bf16)f2bf(ssum / (float)n - w[t & 15]);
                    }
                }
                for (size_t idx = gt; idx < (size_t)DECB * POOLW; idx += gs) {
                    const int b = (int)(idx >> 10), c = (int)(idx & 1023), win = 2 << (c >> 8), row = MP + b;
                    const float cur = bf2f(PROJ[(size_t)row * PROJ_LD + 4096 + c]); const float* sp = ka->state_pool + (size_t)(l * DECB + b) * 15 * 1024; float sacc = cur;
                    for (int j = 1; j < win; ++j) sacc += sp[(15 - j) * 1024 + c];
                    DB[(size_t)row * POOLW + c] = (bf16)f2bf(sacc / (float)win - cur);
                }
                for (size_t idx = gt; idx < (size_t)NB * 3 * 3072; idx += gs) { const int b = (int)(idx / 9216), r = (int)(idx % 9216), i = r / 3072, c = r % 3072;
                    ka->out[O_CP + (size_t)(l * NB + b) * 9216 + r] = bf2f(PROJ[(size_t)(b * SEQ + SEQ - 3 + i) * PROJ_LD + c]); }
                for (size_t idx = gt; idx < (size_t)NB * 15 * 1024; idx += gs) { const int b = (int)(idx / 15360), r = (int)(idx % 15360), i = r / 1024, c = r % 1024;
                    ka->out[O_PP + (size_t)(l * NB + b) * 15360 + r] = bf2f(PROJ[(size_t)(b * SEQ + SEQ - 15 + i) * PROJ_LD + 4096 + c]); }
                for (size_t idx = gt; idx < (size_t)DECB * 3 * 3072; idx += gs) { const int b = (int)(idx / 9216), r = (int)(idx % 9216), i = r / 3072, c = r % 3072;
                    ka->out[O_CS + (size_t)(l * DECB + b) * 9216 + r] = i < 2 ? ka->state_conv[(size_t)(l * DECB + b) * 9216 + (i + 1) * 3072 + c] : bf2f(PROJ[(size_t)(MP + b) * PROJ_LD + c]); }
                for (size_t idx = gt; idx < (size_t)DECB * 15 * 1024; idx += gs) { const int b = (int)(idx / 15360), r = (int)(idx % 15360), i = r / 1024, c = r % 1024;
                    ka->out[O_PS + (size_t)(l * DECB + b) * 15360 + r] = i < 14 ? ka->state_pool[(size_t)(l * DECB + b) * 15360 + (i + 1) * 1024 + c] : bf2f(PROJ[(size_t)(MP + b) * PROJ_LD + 4096 + c]); }
            }
        }
        SEAM(p0 + 1);
        if (IN(p0 + 2)) {
            PHASE_PTRS();
            ScanP SP{WSP(bf16, WS_DW), WSP(bf16, WS_DQG), WSP(bf16, WS_DQK), WSP(bf16, WS_DKD), WSP(float, WS_DU), WSP(float, WS_EGL), WSP(float, WS_OB), WSP(float, WS_OSSQ), ka->out + O_DP + (size_t)l * NB * NH * 16384};
            unsigned* cnt = (unsigned*)(ka->ws + WS_CTL) + CW_SCAN + l * 32 * 64;
            for (int it = bid; it < NB * NH * 8; it += G) { scan_item(lds, SP, it & 31, it >> 5);
                asm volatile("s_waitcnt vmcnt(0)" ::: "memory"); __syncthreads();
                if (threadIdx.x == 0) __hip_atomic_fetch_add(cnt + (it & 31) * 64, 1u, __ATOMIC_RELAXED, __HIP_MEMORY_SCOPE_AGENT); }
            ph_gemm_pool(lds, DB, WpT + (size_t)l * 4 * 65536, CAT, ka->pool_scale + l * POOLW, G, bid);
            {
                int tl = threadIdx.x; asm volatile("" : "+v"(tl)); const int lane = tl & 63, wave = __builtin_amdgcn_readfirstlane(tl >> 6);
                const float* ob = WSP(float, WS_OB); const float* dn = ka->dn_norm + l * HD;
                const float dn0 = dn[lane], dn1 = dn[64 + lane];
                for (int it = bid; it < NB * NH * 8; it += G) { const int bh = it & 31, sl = it >> 5, b = bh >> 3, h = bh & 7;
                    if (threadIdx.x == 0) { unsigned sp = 0;
                        while (__hip_atomic_load(cnt + bh * 64, __ATOMIC_RELAXED, __HIP_MEMORY_SCOPE_AGENT) < 8u) { __builtin_amdgcn_s_sleep(1); if (++sp > (1u << 22)) break; }
                        __builtin_amdgcn_fence(__ATOMIC_ACQUIRE, "agent"); asm volatile("s_waitcnt vmcnt(0)" ::: "memory"); }
                    __syncthreads();
                    for (int tb = 0; tb < 256; tb += 8 * NWAVES) {
                        float a0[8], a1[8]; bf16 z0[8], z1[8];
#pragma unroll
                        for (int i = 0; i < 8; ++i) { const int row = b * SEQ + sl * 256 + tb + i * NWAVES + wave;
                            a0[i] = ob[(size_t)row * DNW + h * 128 + lane]; a1[i] = ob[(size_t)row * DNW + h * 128 + 64 + lane];
                            z0[i] = PROJ[(size_t)row * PROJ_LD + 3072 + h * 128 + lane]; z1[i] = PROJ[(size_t)row * PROJ_LD + 3072 + h * 128 + 64 + lane]; }
#pragma unroll
                        for (int i = 0; i < 8; ++i) { const int row = b * SEQ + sl * 256 + tb + i * NWAVES + wave;
                            const float ss = wave_sum(a0[i] * a0[i] + a1[i] * a1[i]); const float rs = rsqrt_f(ss * (1.0f / 128.f) + EPS);
                            CAT[(size_t)row * DM + h * 128 + lane] = (bf16)f2bf(a0[i] * rs * dn0 * silu_f(bf2f(z0[i])));
                            CAT[(size_t)row * DM + h * 128 + 64 + lane] = (bf16)f2bf(a1[i] * rs * dn1 * silu_f(bf2f(z1[i]))); }
                    }
                }
            }
        }
        SEAM(p0 + 2);
        if (IN(p0 + 3)) {
            PHASE_PTRS();
            ph_gemm_res(lds, CAT, WoutT + (size_t)l * DM * DM, DM, HB, SSQ, G, bid);
            { int si, ns; short_blocks((MP / 256) * (DM / 256), G, bid, si, ns); dec_res_tiles(lds, CAT, DM, WoutT + (size_t)l * DM * DM, HB, WSP(float, WS_DSSQ), si, ns);
              if (l + 1 < DEPTH && G == 256) { const CvP CV{ka->w_in, ka->norm_mix, ka->w_out, ka->w_gate_up, ka->norm_ffn, ka->w_down, ka->w_pool, WinT, WoutT, WguT, WdT, WpT}; convert_tail(CV, lds, l + 1, CV_A + CV_B, bid - 64, 192, CV_C, CV_PW_C); } }
        }
        SEAM(p0 + 3);
        if (IN(p0 + 4)) {
            PHASE_PTRS();
            ph_gemm_gu(lds, HB, WguT + (size_t)l * 2 * DFF * DM, ACT, SSQ, G, bid);
            { int si, ns; short_blocks((MP / 256) * (2 * DFF / 256), G, bid, si, ns); dec_gu_tiles(lds, HB, WguT + (size_t)l * 2 * DFF * DM, ACT, WSP(float, WS_DSSQ), si, ns);
              if (l + 1 < DEPTH && G == 256) { const CvP CV{ka->w_in, ka->norm_mix, ka->w_out, ka->w_gate_up, ka->norm_ffn, ka->w_down, ka->w_pool, WinT, WoutT, WguT, WdT, WpT}; convert_tail(CV, lds, l + 1, CV_A, si, ns, CV_B); } }
        }
        SEAM(p0 + 4);
        if (IN(p0 + 5)) {
            PHASE_PTRS();
            ph_gemm_res(lds, ACT, WdT + (size_t)l * DM * DFF, DFF, HB, SSQ, G, bid);
            { int si, ns; short_blocks((MP / 256) * (DM / 256), G, bid, si, ns); dec_res_tiles(lds, ACT, DFF, WdT + (size_t)l * DM * DFF, HB, WSP(float, WS_DSSQ), si, ns);
              if (l + 1 < DEPTH && G == 256) { const CvP CV{ka->w_in, ka->norm_mix, ka->w_out, ka->w_gate_up, ka->norm_ffn, ka->w_down, ka->w_pool, WinT, WoutT, WguT, WdT, WpT}; convert_tail(CV, lds, l + 1, CV_A + CV_B + CV_C, bid - 64, 192, CV_D, CV_PW_D); } }
        }
        SEAM(p0 + 5);
    }
__global__ void __launch_bounds__(NTHR, 2) fwd(Args a) {
    extern __shared__ __attribute__((aligned(16))) unsigned char lds_raw[];
    LAS unsigned char* lds = (LAS unsigned char*)lds_raw;
    volatile LAS unsigned* MISC = (volatile LAS unsigned*)(lds + MISC_OFF);
    const int tid = threadIdx.x, lane = tid & 63, wave = __builtin_amdgcn_readfirstlane(tid >> 6);
    const int G = gridDim.x, bid = blockIdx.x;
    unsigned* ctl = (unsigned*)(KA->ws + WS_CTL);
    if (tid < 32) MISC[tid] = 0u;
    __syncthreads();
    const int lo = KA->ph_lo, hi = KA->ph_hi;
    if (hi - lo > 1) (void)xcd_barrier_post(ctl + CW_BAR, MISC + 8);

    const int gw = bid * NWAVES + wave, NGW = G * NWAVES;

    if (IN(0)) {
        PHASE_PTRS();
        int tl = threadIdx.x; asm volatile("" : "+v"(tl)); const int lane = tl & 63, wave = __builtin_amdgcn_readfirstlane(tl >> 6), gw = bid * NWAVES + wave;
        LAS float* scr = (LAS float*)(lds + wave * 16384);
        const CvP CV{ka->w_in, ka->norm_mix, ka->w_out, ka->w_gate_up, ka->norm_ffn, ka->w_down, ka->w_pool, WinT, WoutT, WguT, WdT, WpT};
        const int skip = (G == 256) ? CV_END : 0;
        for (int it = gw; it < DEPTH * I_L; it += NGW) {
            const int l = it / I_L, r = it - l * I_L;
            if (l > 0 && r < skip) continue;
            convert_item(CV, l, r, scr, lane);
        }
        for (int m = gw; m < MPAD; m += NGW) {
            const float* src = m < MP ? ka->x_prompt + (size_t)m * DM : (m < MR ? ka->x_sample + (size_t)(m - MP) * DM : nullptr);
            float s = 0.f;
#pragma unroll
            for (int j = 0; j < 8; ++j) { f32x4 v = src ? *((const f32x4*)src + lane + 64 * j) : (f32x4){0.f, 0.f, 0.f, 0.f};
                s += (v[0] * v[0] + v[1] * v[1]) + (v[2] * v[2] + v[3] * v[3]);
                v2u w; w.x = pk2(v[0], v[1]); w.y = pk2(v[2], v[3]); *((v2u*)(HB + (size_t)m * DM) + lane + 64 * j) = w; }
            s = wave_sum(s);
            if (lane < 32) SSQ[(size_t)m * 32 + lane] = lane == 0 ? s : 0.f;
            if (m >= MP && m < MR) WSP(float, WS_DSSQ)[(size_t)(m - MP) * 64 + lane] = lane == 0 ? s : 0.f;
        }
    }
    SEAM(0);

    layer_phases<0>(lds, lo, hi, G, bid);
    layer_phases<1>(lds, lo, hi, G, bid);
    layer_phases<2>(lds, lo, hi, G, bid);
    layer_phases<3>(lds, lo, hi, G, bid);
    if (IN(N_PHASES - 1)) {
        PHASE_PTRS();
        int tl = threadIdx.x; asm volatile("" : "+v"(tl)); const int lane = tl & 63, gw = bid * NWAVES + __builtin_amdgcn_readfirstlane(tl >> 6);
        for (int m = gw; m < MR; m += NGW) {
            float r;
            if (m < MP) { const f32x4* p = (const f32x4*)(SSQ + (size_t)m * 32); float s = 0.f;
#pragma unroll
                for (int j = 0; j < 8; ++j) { const f32x4 v = p[j]; s += (v[0] + v[1]) + (v[2] + v[3]); }
                r = rsqrt_f(s * (1.0f / DM) + EPS); }
            else r = dec_row_scale(WSP(float, WS_DSSQ), m - MP);
#pragma unroll
            for (int j = 0; j < 8; ++j) { const v2u hv = *((const v2u*)(HB + (size_t)m * DM) + lane + 64 * j); const f32x4 w = *((const f32x4*)ka->norm_final + lane + 64 * j);
                const f32x4 v = (f32x4){__builtin_bit_cast(float, hv.x << 16), __builtin_bit_cast(float, hv.x & 0xffff0000u), __builtin_bit_cast(float, hv.y << 16), __builtin_bit_cast(float, hv.y & 0xffff0000u)};
                *((f32x4*)(ka->out + O_YP + (size_t)m * DM) + lane + 64 * j) = v * r * w; }
        }
    }
}

extern "C" void kernel_launch(void* const* d_in, const int* in_sizes, int n_in, void* d_out, int out_size, void* d_ws, size_t ws_size, hipStream_t stream) {
    static int grid = 0;
    if (grid == 0) {
        if (n_in != 18 || (size_t)out_size != O_END || ws_size < WS_END) { fprintf(stderr, "kernel_launch: unexpected shapes (n_in %d out %d ws %zu need %zu)\n", n_in, out_size, ws_size, (size_t)WS_END); grid = -1; return; }
        int dev = 0, cus = 0, per_cu = 0;
        if (hipGetDevice(&dev) != hipSuccess || hipDeviceGetAttribute(&cus, hipDeviceAttributeMultiprocessorCount, dev) != hipSuccess) { grid = -1; return; }
        if (hipFuncSetAttribute((const void*)fwd, hipFuncAttributeMaxDynamicSharedMemorySize, LDS_BYTES) != hipSuccess) { fprintf(stderr, "kernel_launch: hipFuncSetAttribute failed\n"); grid = -1; return; }
        if (hipOccupancyMaxActiveBlocksPerMultiprocessor(&per_cu, (const void*)fwd, NTHR, LDS_BYTES) != hipSuccess || per_cu < 1) { fprintf(stderr, "kernel_launch: occupancy query says %d\n", per_cu); }
        (void)hipGetLastError();
        grid = cus;
    }
    if (grid < 0) return;
    (void)hipMemsetAsync((char*)d_ws + WS_CTL, 0, CTL_ZERO_BYTES, stream);
    Args a{};
    a.x_prompt = (const float*)d_in[0]; a.x_sample = (const float*)d_in[1]; a.state_delta = (const float*)d_in[2]; a.state_conv = (const float*)d_in[3]; a.state_pool = (const float*)d_in[4];
    a.norm_mix = (const float*)d_in[5]; a.w_in = (const float*)d_in[6]; a.conv_w = (const float*)d_in[7]; a.a_log = (const float*)d_in[8]; a.dt_bias = (const float*)d_in[9];
    a.dn_norm = (const float*)d_in[10]; a.w_pool = (const float*)d_in[11]; a.pool_scale = (const float*)d_in[12]; a.w_out = (const float*)d_in[13]; a.norm_ffn = (const float*)d_in[14];
    a.w_gate_up = (const float*)d_in[15]; a.w_down = (const float*)d_in[16]; a.norm_final = (const float*)d_in[17];
    a.out = (float*)d_out; a.ws = (unsigned char*)d_ws;
#if MK_N_LAUNCHES == 1
    a.ph_lo = 0; a.ph_hi = N_PHASES;
    hipLaunchKernelGGL(fwd, dim3(grid), dim3(NTHR), LDS_BYTES, stream, a);
#else
    for (int p = 0; p < N_PHASES; ++p) { a.ph_lo = p; a.ph_hi = p + 1; hipLaunchKernelGGL(fwd, dim3(grid), dim3(NTHR), LDS_BYTES, stream, a); }
#endif
}
```
